# Optimizing an MI355X kernel written in HIP

```python
import jax, jax.numpy as jnp
from jax import lax
import numpy as np

D_MODEL = 1024
BATCH = 2
SEQ = 8192
DEPTH = 2

HGRN_HEADS = 4
HGRN_KEY = 128
HGRN_VAL = 128
HGRN_KW = HGRN_HEADS * HGRN_KEY
HGRN_VW = HGRN_HEADS * HGRN_VAL
HGRN_CHUNK = 64
POOL_WINDOWS = (2, 4, 8, 16)
POOL_GROUP = 128
POOL_WIDTH = POOL_GROUP * len(POOL_WINDOWS)
FOX_HEADS = 16
FOX_HEAD_DIM = 64
FOX_WIDTH = FOX_HEADS * FOX_HEAD_DIM
FOX_BLOCK = 128
EVEN_IN = 2 * HGRN_KW + 2 * HGRN_VW + 2 * POOL_WIDTH
EVEN_MIX = HGRN_VW + POOL_WIDTH
ODD_IN = 4 * FOX_WIDTH + FOX_HEADS
N_EVEN = (DEPTH + 1) // 2
N_ODD = DEPTH // 2
EPS = 1e-6

kernel_name = 'hybrid_hgrn2_pool_fox_adaln'


def rms_norm(x, g):
    xf = x.astype(jnp.float32)
    y = xf * lax.rsqrt(jnp.mean(xf * xf, axis=-1, keepdims=True) + EPS)
    return (y * g.astype(jnp.float32)).astype(x.dtype)


def hgrn2_chunked(q, k, v, logf):
    b_, s_, h_, kd = q.shape
    vd = v.shape[-1]
    nc = s_ // HGRN_CHUNK

    def to_chunks(t):
        return t.reshape(b_, nc, HGRN_CHUNK, h_, t.shape[-1]).transpose(1, 0, 3, 2, 4)

    causal = jnp.tril(jnp.ones((HGRN_CHUNK, HGRN_CHUNK), dtype=bool))

    def step(state, inp):
        qc, kc, vc, gc = inp
        cum = jnp.cumsum(gc, axis=2)
        diff = cum[:, :, :, None, :] - cum[:, :, None, :, :]
        decay = jnp.where(causal[:, :, None], jnp.exp(jnp.minimum(diff, 0.0)), 0.0)
        scores = jnp.einsum('bhtk,bhsk,bhtsk->bhts', qc, kc, decay)
        out = (jnp.einsum('bhts,bhsv->bhtv', scores, vc)
               + jnp.einsum('bhtk,bhkv->bhtv', qc * jnp.exp(cum), state))
        last = cum[:, :, -1:, :]
        state = (jnp.exp(last[:, :, 0, :])[..., None] * state
                 + jnp.einsum('bhsk,bhsv->bhkv', kc * jnp.exp(last - cum), vc))
        return state, out

    s0 = jnp.zeros((b_, h_, kd, vd), jnp.float32)
    _, out = lax.scan(step, s0, (to_chunks(q), to_chunks(k), to_chunks(v), to_chunks(logf)))
    return out.transpose(1, 0, 3, 2, 4).reshape(b_, s_, h_, vd)


def multiscale_pool(u):
    b_, s_, _ = u.shape
    groups = u.reshape(b_, s_, len(POOL_WINDOWS), POOL_GROUP)
    csum = jnp.cumsum(groups, axis=1)
    csum = jnp.concatenate([jnp.zeros_like(csum[:, :1]), csum], axis=1)
    pos = jnp.arange(s_)
    outs = []
    for gi, w in enumerate(POOL_WINDOWS):
        cg = csum[:, :, gi]
        lagged = jnp.concatenate([jnp.zeros((b_, w - 1, POOL_GROUP), cg.dtype), cg[:, :s_ - w + 1]], axis=1)
        count = jnp.minimum(pos + 1, w).astype(cg.dtype)[None, :, None]
        outs.append((cg[:, 1:] - lagged) / count - groups[:, :, gi])
    return jnp.stack(outs, axis=2)


def even_mixer(h, w_in, lower, onorm_g, pool_w, pool_scale, w_out):
    b_, s_, _ = h.shape
    proj = (h @ w_in).astype(jnp.float32)
    cuts = [HGRN_KW, 2 * HGRN_KW, 2 * HGRN_KW + HGRN_VW, 2 * HGRN_KW + 2 * HGRN_VW,
            2 * HGRN_KW + 2 * HGRN_VW + POOL_WIDTH]
    q, f, i, g_a, u, g_b = jnp.split(proj, cuts, axis=-1)
    lb = lower.astype(jnp.float32)
    forget = lb + (1.0 - lb) * jax.nn.sigmoid(f)
    logf = jnp.log(forget)
    key = 1.0 - forget
    kh = lambda t: t.reshape(b_, s_, HGRN_HEADS, HGRN_KEY)
    o_a = hgrn2_chunked(kh(q), kh(key), i.reshape(b_, s_, HGRN_HEADS, HGRN_VAL), kh(logf))
    o_a = rms_norm(o_a, onorm_g.reshape(HGRN_HEADS, HGRN_VAL)).reshape(b_, s_, HGRN_VW) * jax.nn.silu(g_a)
    pooled = multiscale_pool(u)
    o_b = jnp.einsum('bsgc,gcd->bsgd', pooled, pool_w.astype(jnp.float32)).reshape(b_, s_, POOL_WIDTH)
    o_b = o_b * pool_scale.astype(jnp.float32) * jax.nn.silu(g_b)
    mixed = jnp.concatenate([o_a, o_b], axis=-1).astype(h.dtype)
    return mixed @ w_out


def odd_mixer(h, w_in, b_f, qnorm_g, knorm_g, w_out):
    b_, s_, _ = h.shape
    proj = (h @ w_in).astype(jnp.float32)
    q, k, v, g, fl = jnp.split(proj, [FOX_WIDTH, 2 * FOX_WIDTH, 3 * FOX_WIDTH, 4 * FOX_WIDTH], axis=-1)
    hd = lambda t: t.reshape(b_, s_, FOX_HEADS, FOX_HEAD_DIM)
    q = rms_norm(hd(q), qnorm_g).transpose(0, 2, 1, 3)
    k = rms_norm(hd(k), knorm_g).transpose(0, 2, 1, 3)
    v = hd(v).transpose(0, 2, 1, 3)
    logf = jax.nn.log_sigmoid(fl + b_f.astype(jnp.float32))
    cumf = jnp.cumsum(logf, axis=1).transpose(0, 2, 1)
    scale = FOX_HEAD_DIM ** -0.5
    outs = []
    for blk in range(s_ // FOX_BLOCK):
        q0 = blk * FOX_BLOCK
        q1 = q0 + FOX_BLOCK
        logits = (jnp.einsum('bhqd,bhkd->bhqk', q[:, :, q0:q1], k[:, :, :q1]) * scale
                  + cumf[:, :, q0:q1, None] - cumf[:, :, None, :q1])
        mask = jnp.arange(q0, q1)[:, None] >= jnp.arange(q1)[None, :]
        probs = jax.nn.softmax(jnp.where(mask, logits, -jnp.inf), axis=-1)
        outs.append(jnp.einsum('bhqk,bhkd->bhqd', probs, v[:, :, :q1]))
    o = jnp.concatenate(outs, axis=2).transpose(0, 2, 1, 3).reshape(b_, s_, FOX_WIDTH)
    o = o * jax.nn.silu(g)
    return o.astype(h.dtype) @ w_out


def setup_inputs(seed: int = 0) -> dict:
    key = jax.random.key(seed)
    ks = jax.random.split(key, 16)
    nrm = jax.random.normal
    f32 = jnp.float32
    return {
        'x': nrm(ks[0], (BATCH, SEQ, D_MODEL), f32),
        'c': nrm(ks[1], (BATCH, D_MODEL), f32),
        'norm_g': 1.0 + 0.05 * nrm(ks[2], (DEPTH, D_MODEL), f32),
        'ada_w': 0.5 * D_MODEL ** -0.5 * nrm(ks[3], (DEPTH, D_MODEL, 3 * D_MODEL), f32),
        'ada_b': 0.02 * nrm(ks[4], (DEPTH, 3 * D_MODEL), f32),
        'hgrn_lb': 0.1 * nrm(ks[5], (DEPTH + 1, HGRN_KW), f32),
        'even_w_in': D_MODEL ** -0.5 * nrm(ks[6], (N_EVEN, D_MODEL, EVEN_IN), f32),
        'hgrn_onorm_g': 1.0 + 0.05 * nrm(ks[7], (N_EVEN, HGRN_VW), f32),
        'pool_w': POOL_GROUP ** -0.5 * nrm(ks[8], (N_EVEN, len(POOL_WINDOWS), POOL_GROUP, POOL_GROUP), f32),
        'pool_scale': 1.0 + 0.05 * nrm(ks[9], (N_EVEN, POOL_WIDTH), f32),
        'even_w_out': EVEN_MIX ** -0.5 * nrm(ks[10], (N_EVEN, EVEN_MIX, D_MODEL), f32),
        'odd_w_in': D_MODEL ** -0.5 * nrm(ks[11], (N_ODD, D_MODEL, ODD_IN), f32),
        'fox_b_f': jax.random.uniform(ks[12], (N_ODD, FOX_HEADS), f32, 1.0, 4.0),
        'fox_qnorm_g': 1.0 + 0.05 * nrm(ks[13], (N_ODD, FOX_HEAD_DIM), f32),
        'fox_knorm_g': 1.0 + 0.05 * nrm(ks[14], (N_ODD, FOX_HEAD_DIM), f32),
        'odd_w_out': FOX_WIDTH ** -0.5 * nrm(ks[15], (N_ODD, FOX_WIDTH, D_MODEL), f32),
    }


def reference(x, c, norm_g, ada_w, ada_b, hgrn_lb, even_w_in, hgrn_onorm_g, pool_w, pool_scale,
              even_w_out, odd_w_in, fox_b_f, fox_qnorm_g, fox_knorm_g, odd_w_out):
    lower = jnp.cumsum(jax.nn.softmax(hgrn_lb.astype(jnp.float32), axis=0), axis=0)
    cond = jax.nn.silu(c)
    for l in range(DEPTH):
        mod = cond @ ada_w[l] + ada_b[l]
        shift, scale, gate = jnp.split(mod, 3, axis=-1)
        h = rms_norm(x, norm_g[l]) * (1.0 + scale[:, None, :]) + shift[:, None, :]
        j = l // 2
        if l % 2 == 0:
            y = even_mixer(h, even_w_in[j], lower[l], hgrn_onorm_g[j], pool_w[j], pool_scale[j], even_w_out[j])
        else:
            y = odd_mixer(h, odd_w_in[j], fox_b_f[j], fox_qnorm_g[j], fox_knorm_g[j], odd_w_out[j])
        x = x + gate[:, None, :] * y
    return x
```

```cpp
#include <hip/hip_runtime.h>
#include <cstdio>
#include <cstdint>
namespace pg8 {
#define PG8_LAS __attribute__((address_space(3)))
typedef unsigned short bf16_t;
typedef short bf16x8 __attribute__((ext_vector_type(8)));
typedef float f32x4 __attribute__((ext_vector_type(4)));
typedef unsigned u32x4 __attribute__((ext_vector_type(4)));
constexpr int BM = 256, BK = 64, HALF = 128, HTB = HALF * BK * 2  , STAGE_BYTES = 8 * HTB, NXCD = 8, WGM = 8;

__host__ __device__ __forceinline__ int lds_byte(int r, int c) { const int st = (r >> 4) * 2 + (c >> 5), rr = r & 15, cc = c & 31, ob = rr * 64 + cc * 2; return st * 1024 + (ob ^ (((ob >> 9) & 1) << 5)); }
__host__ __device__ __forceinline__ void stage_rc(int b, int& R, int& C) { const int st = b / 1024, sb = b % 1024, swz = sb ^ (((sb >> 9) & 1) << 5); R = (st >> 1) * 16 + swz / 64; C = (st & 1) * 32 + (swz % 64) / 2; }
__host__ __device__ __forceinline__ int perm32(int rho) { const int n = rho >> 4, i = rho & 15; return 8 * (i >> 2) + 4 * n + (i & 3); }

struct Unit { int pm, pn; };
struct Gemm { const bf16_t* A; const bf16_t* Bt; int M, N, K; };

struct StaticOrder {
    int nM, nN, nwg, G, c;
    __host__ __device__ void init(int M, int N, int G_, int c_) { nM = M / BM; nN = N / BM; nwg = nM * nN; G = G_; c = c_; }
    __host__ __device__ bool next(int i, Unit& u) const {
        const long L = (long)i * G + c; if (L >= nwg) return false;
        int wgid = (int)L; { const int q = nwg / NXCD, r = nwg % NXCD, xcd = wgid % NXCD, off = wgid / NXCD; wgid = (xcd < r ? xcd * (q + 1) : r * (q + 1) + (xcd - r) * q) + off; }
        const int nig = WGM * nN, gid = wgid / nig, fm = gid * WGM, gsz = (nM - fm) < WGM ? (nM - fm) : WGM;
        u.pm = fm + ((wgid % nig) % gsz); u.pn = (wgid % nig) / gsz; return true;
    }
    __device__ __forceinline__ void a_ready(const Unit&) const {}
    __device__ __forceinline__ void done(const Unit&) const {}
};

__device__ __forceinline__ unsigned cvt_pk_bf16(float lo, float hi) { unsigned r; asm volatile("v_cvt_pk_bf16_f32 %0, %1, %2" : "=v"(r) : "v"(lo), "v"(hi)); return r; }
__device__ __forceinline__ void st16_wt(void* p, u32x4 v) { asm volatile("global_store_dwordx4 %0, %1, off sc1\n\ts_nop 1" :: "v"(p), "v"(v) : "memory"); }
typedef float f32x2 __attribute__((ext_vector_type(2)));
__device__ __forceinline__ f32x2 gelu_pk(f32x2 v) {
    const f32x2 av = __builtin_elementwise_abs(v), d = av * 0.2316418882f + 1.0f;
    f32x2 t; t.x = __builtin_amdgcn_rcpf(d.x); t.y = __builtin_amdgcn_rcpf(d.y);
    f32x2 q = t * 0.5307027145f + (-0.7265760135f); q = q * t + 0.7107068705f; q = q * t + (-0.142248368f); q = q * t + 0.127414796f; q = q * t;
    const f32x2 s = (v * v) * (-0.72134752044f);
    f32x2 e; e.x = __builtin_amdgcn_exp2f(s.x); e.y = __builtin_amdgcn_exp2f(s.y);
    const f32x2 m = v * (q * e), r = v - m;
    f32x2 o; o.x = v.x < 0.f ? m.x : r.x; o.y = v.y < 0.f ? m.y : r.y; return o;
}

template <int ACT  > struct EpiBf16 {
    static constexpr bool PERM = true, AFTER_DRAIN = false; static_assert(ACT == 0 || ACT == 1, "EpiBf16: ACT is 0 (none) or 1 (gelu_pk)");
    bf16_t* O; int ldc; const float* bias; int split_cols; size_t split_stride; float scale0;
    __device__ __forceinline__ void operator()(const f32x4 (&acc)[2][2][4][2], const Unit& u, int wr, int wc, int fr, int fq) const {
        const int row0 = u.pm * BM + wr * 64 + fr; int colt = u.pn * BM; bf16_t* base = O;
        float sc = 1.f; if (split_cols) { const int t = colt / split_cols; base += (size_t)t * split_stride; colt -= t * split_cols; if (t == 0) sc = scale0; }
        const int col0 = colt + wc * 32 + 8 * fq, bcol0 = u.pn * BM + wc * 32 + 8 * fq;
        f32x4 bv[2][2];
#pragma unroll
        for (int bj = 0; bj < 2; ++bj)
#pragma unroll
            for (int n = 0; n < 2; ++n) bv[bj][n] = bias ? *(const f32x4*)(bias + bcol0 + bj * HALF + 4 * n) : (f32x4){0.f, 0.f, 0.f, 0.f};
#pragma unroll
        for (int ai = 0; ai < 2; ++ai)
#pragma unroll
            for (int m = 0; m < 4; ++m) { bf16_t* rowp = base + (size_t)(row0 + ai * HALF + m * 16) * ldc + col0;
#pragma unroll
                for (int bj = 0; bj < 2; ++bj) { f32x4 v0 = acc[ai][bj][m][0] + bv[bj][0], v1 = acc[ai][bj][m][1] + bv[bj][1];
                    if (ACT == 1) { f32x2 a = gelu_pk((f32x2){v0[0], v0[1]}), b = gelu_pk((f32x2){v0[2], v0[3]}), c = gelu_pk((f32x2){v1[0], v1[1]}), d = gelu_pk((f32x2){v1[2], v1[3]});
                        v0 = (f32x4){a.x, a.y, b.x, b.y}; v1 = (f32x4){c.x, c.y, d.x, d.y}; }
                    v0 = v0 * sc; v1 = v1 * sc; u32x4 w; w.x = cvt_pk_bf16(v0[0], v0[1]); w.y = cvt_pk_bf16(v0[2], v0[3]); w.z = cvt_pk_bf16(v1[0], v1[1]); w.w = cvt_pk_bf16(v1[2], v1[3]);
                    st16_wt(rowp + bj * HALF, w); } }
    }
};
struct EpiOdd {
    static constexpr bool PERM = true, AFTER_DRAIN = false;
    float c2; void* pA; const float* pB; const float* pC; const float* pD; const float* pE;
    __device__ __forceinline__ void operator()(const f32x4 (&acc)[2][2][4][2], const Unit& u, int wr, int wc, int fr, int fq) const {
        const int row0 = u.pm * BM + wr * 64 + fr;
        {
            bf16_t* QKVG = (bf16_t*)pA; const float* gq = pB; const float* gk = pC; const float* biasp = pD; const float* rowss = pE;
            const int type = u.pn >> 2, head = 4 * (u.pn & 3) + wc;
            bf16_t* base = QKVG + (size_t)type * ((size_t)16384 * 1024) + head * 64 + 8 * fq;
            const float* bp = biasp + (u.pm >= 32 ? 4352 : 0) + u.pn * BM + wc * 32 + 8 * fq;
            f32x4 gg[2][2], bb[2][2];
#pragma unroll
            for (int bj = 0; bj < 2; ++bj)
#pragma unroll
                for (int n = 0; n < 2; ++n) { f32x4 g1 = (f32x4){1.f, 1.f, 1.f, 1.f};
                    if (type == 0) g1 = *(const f32x4*)(gq + 32 * bj + 8 * fq + 4 * n) * c2; else if (type == 1) g1 = *(const f32x4*)(gk + 32 * bj + 8 * fq + 4 * n);
                    gg[bj][n] = g1; bb[bj][n] = *(const f32x4*)(bp + bj * HALF + 4 * n); }
            float rr8[2][4];
#pragma unroll
            for (int ai = 0; ai < 2; ++ai)
#pragma unroll
                for (int m = 0; m < 4; ++m) rr8[ai][m] = rowss[row0 + ai * HALF + m * 16];
#pragma unroll
            for (int ai = 0; ai < 2; ++ai)
#pragma unroll
                for (int m = 0; m < 4; ++m) {
                    const int row = row0 + ai * HALF + m * 16;
                    const float rrow = __builtin_amdgcn_rsqf(rr8[ai][m] * (1.0f / 1024.0f) + 1e-6f);
                    f32x4 v[2][2];
#pragma unroll
                    for (int bj = 0; bj < 2; ++bj)
#pragma unroll
                        for (int n = 0; n < 2; ++n) v[bj][n] = acc[ai][bj][m][n] * rrow + bb[bj][n];
                    float rs = 1.f;
                    if (type < 2) { float ss = 0.f;
#pragma unroll
                        for (int bj = 0; bj < 2; ++bj)
#pragma unroll
                            for (int n = 0; n < 2; ++n) { const f32x4 x = v[bj][n]; ss += (x[0] * x[0] + x[1] * x[1]) + (x[2] * x[2] + x[3] * x[3]); }
                        ss += __shfl_xor(ss, 16); ss += __shfl_xor(ss, 32);
                        rs = __builtin_amdgcn_rsqf(ss * (1.0f / 64.0f) + 1e-6f); }
                    bf16_t* rowp = base + (size_t)row * 1024;
#pragma unroll
                    for (int bj = 0; bj < 2; ++bj) { const f32x4 v0 = v[bj][0] * rs * gg[bj][0], v1 = v[bj][1] * rs * gg[bj][1];
                        u32x4 w; w.x = cvt_pk_bf16(v0[0], v0[1]); w.y = cvt_pk_bf16(v0[2], v0[3]); w.z = cvt_pk_bf16(v1[0], v1[1]); w.w = cvt_pk_bf16(v1[2], v1[3]);
                        st16_wt(rowp + 32 * bj, w); } }
        }
    }
};
template <bool FUSE> struct EpiResid {
    static constexpr bool PERM = true, AFTER_DRAIN = false; static constexpr int kind = FUSE ? 2 : 1, MB = FUSE ? 2 : 4;
    int ival; void* pA; const float* pB; const float* pC; const float* pD; const float* pE; bf16_t* pF; float* pG;
    __device__ __forceinline__ void operator()(const f32x4 (&acc)[2][2][4][2], const Unit& u, int wr, int wc, int fr, int fq) const {
        const int row0 = u.pm * BM + wr * 64 + fr;
        {
            float* out = (float*)pA; const float* base = pB; const float* gate = pC; const float* ng = pD; const float* scl = pE; bf16_t* A1 = pF; float* rowss = pG;
            const int col0 = u.pn * BM + wc * 32 + 8 * fq; const int bo = (u.pm >= 32) ? ival : 0;
            f32x4 gv[2][2], gm[2][2];
#pragma unroll
            for (int bj = 0; bj < 2; ++bj)
#pragma unroll
                for (int n = 0; n < 2; ++n) { gv[bj][n] = *(const f32x4*)(gate + bo + col0 + bj * HALF + 4 * n);
                    if (kind == 2) gm[bj][n] = *(const f32x4*)(ng + col0 + bj * HALF + 4 * n) * (*(const f32x4*)(scl + bo + col0 + bj * HALF + 4 * n) + 1.0f); }
#pragma unroll
            for (int ai = 0; ai < 2; ++ai)
#pragma unroll
                for (int mp = 0; mp < 4 / MB; ++mp) {
                    f32x4 bs[MB][2][2];
#pragma unroll
                    for (int mi = 0; mi < MB; ++mi) { const size_t off = (size_t)(row0 + ai * HALF + (MB * mp + mi) * 16) * 1024 + col0;
#pragma unroll
                        for (int bj = 0; bj < 2; ++bj)
#pragma unroll
                            for (int n = 0; n < 2; ++n) bs[mi][bj][n] = *(const f32x4*)(base + off + bj * HALF + 4 * n); }
#pragma unroll
                    for (int mi = 0; mi < MB; ++mi) { const int m = MB * mp + mi; const int row = row0 + ai * HALF + m * 16; const size_t off = (size_t)row * 1024 + col0;
                        float ss = 0.f;
#pragma unroll
                        for (int bj = 0; bj < 2; ++bj) { f32x4 x1[2];
#pragma unroll
                            for (int n = 0; n < 2; ++n) { x1[n] = bs[mi][bj][n] + gv[bj][n] * acc[ai][bj][m][n];
                                *(f32x4*)(out + off + bj * HALF + 4 * n) = x1[n]; }
                            if (kind == 2) { ss += (x1[0][0] * x1[0][0] + x1[0][1] * x1[0][1]) + (x1[0][2] * x1[0][2] + x1[0][3] * x1[0][3]) + (x1[1][0] * x1[1][0] + x1[1][1] * x1[1][1]) + (x1[1][2] * x1[1][2] + x1[1][3] * x1[1][3]);
                                const f32x4 a0 = x1[0] * gm[bj][0], a1 = x1[1] * gm[bj][1];
                                u32x4 w; w.x = cvt_pk_bf16(a0[0], a0[1]); w.y = cvt_pk_bf16(a0[2], a0[3]); w.z = cvt_pk_bf16(a1[0], a1[1]); w.w = cvt_pk_bf16(a1[2], a1[3]);
                                *(u32x4*)(A1 + off + bj * HALF) = w; } }
                        if (kind == 2) { ss += __shfl_xor(ss, 16); ss += __shfl_xor(ss, 32); if (fq == 0) atomicAdd(rowss + row, ss); } }
                    asm volatile("" ::: "memory");
                }
        }
    }
};
template <class Epi, class Sched, bool ALIGN_EPI = false, bool SP2 = false>
__device__ __forceinline__ void gemm_phase(PG8_LAS unsigned char* lds, const Gemm g, const Sched& S, const Epi& E) {
    int tid = threadIdx.x; asm volatile("" : "+v"(tid)); const int wid = __builtin_amdgcn_readfirstlane(tid >> 6), lane = tid & 63, wr = wid >> 2, wc = wid & 3, fr = lane & 15, fq = lane >> 4;
    const int K = g.K, nt = K / BK;
    unsigned voffA[2], voffB[2];
#pragma unroll
    for (int i = 0; i < 2; ++i) { int R, C; stage_rc(tid * 16 + i * 8192, R, C); const int Rb = Epi::PERM ? ((R & ~31) + perm32(R & 31)) : R;
        voffA[i] = (unsigned)(R * K + C) * 2u; voffB[i] = (unsigned)(Rb * K + C) * 2u; }
    const size_t kstep = (size_t)(BK * 2);
    const size_t hstep = (size_t)HALF * K * 2;
    const size_t tstep = 2 * hstep;
    const unsigned ldsw = (unsigned)wid * 1024u;
    const int aoff = lds_byte(wr * 64 + fr, fq * 8), boff = lds_byte(wc * 32 + fr, fq * 8);
#define PG8_SA(b, h) (((b) * 2 + (h)) * HTB)
#define PG8_SB(b, h) ((4 + (b) * 2 + (h)) * HTB)
#define PG8_STAGE(bufoff, gbase, voff) do { _Pragma("unroll") for (int _i = 0; _i < 2; ++_i) \
        __builtin_amdgcn_global_load_lds((const unsigned*)((const char*)(gbase) + (voff)[_i]), (PG8_LAS unsigned*)(lds + (bufoff) + ldsw + _i * 8192), 16, 0, 0); } while (0)
#define PG8_LDA(dst, b, h) do { _Pragma("unroll") for (int m = 0; m < 4; ++m) _Pragma("unroll") for (int k = 0; k < 2; ++k) dst[m][k] = *(const PG8_LAS bf16x8*)(lds + PG8_SA(b, h) + aoff + m * 2048 + k * 1024); } while (0)
#define PG8_LDB(dst, b, h) do { _Pragma("unroll") for (int n = 0; n < 2; ++n) _Pragma("unroll") for (int k = 0; k < 2; ++k) dst[n][k] = *(const PG8_LAS bf16x8*)(lds + PG8_SB(b, h) + boff + n * 2048 + k * 1024); } while (0)
#define PG8_MMA(ai, bj, At, Bt) do { __builtin_amdgcn_s_setprio(1); _Pragma("unroll") for (int m = 0; m < 4; ++m) _Pragma("unroll") for (int n = 0; n < 2; ++n) _Pragma("unroll") for (int k = 0; k < 2; ++k) \
        acc[ai][bj][m][n] = __builtin_amdgcn_mfma_f32_16x16x32_bf16(Bt[n][k], At[m][k], acc[ai][bj][m][n], 0, 0, 0); __builtin_amdgcn_s_setprio(0); } while (0)
#define PG8_WAIT_V(n) asm volatile("s_waitcnt vmcnt(" #n ")" ::: "memory")
#define PG8_WAIT_L(n) asm volatile("s_waitcnt lgkmcnt(" #n ")" ::: "memory")
#define PG8_BAR __builtin_amdgcn_s_barrier()
#define PG8_SCHED __builtin_amdgcn_sched_barrier(0)
    Unit cur, nxt; int ui = 0;
    if (!S.next(0, cur)) return;
    f32x4 acc[2][2][4][2];
#pragma unroll
    for (int a = 0; a < 2; ++a)
#pragma unroll
        for (int b = 0; b < 2; ++b)
#pragma unroll
            for (int m = 0; m < 4; ++m)
#pragma unroll
                for (int n = 0; n < 2; ++n) acc[a][b][m][n] = (f32x4){0.f, 0.f, 0.f, 0.f};
    bf16x8 At[4][2], B0[2][2], B1[2][2];
    const char* cA = (const char*)g.A + (size_t)cur.pm * tstep; const char* cB = (const char*)g.Bt + (size_t)cur.pn * tstep;
    S.a_ready(cur);
    if constexpr (SP2) {
        PG8_STAGE(PG8_SB(0, 0), cB, voffB); PG8_STAGE(PG8_SB(0, 1), cB + hstep, voffB); PG8_STAGE(PG8_SA(0, 0), cA, voffA); PG8_STAGE(PG8_SA(0, 1), cA + hstep, voffA);
        if (wr == 1) PG8_BAR;
        PG8_WAIT_V(2); PG8_BAR;
        PG8_STAGE(PG8_SB(1, 0), cB + kstep, voffB); PG8_STAGE(PG8_SA(1, 0), cA + kstep, voffA); PG8_STAGE(PG8_SB(1, 1), cB + hstep + kstep, voffB);
        PG8_WAIT_V(6); PG8_BAR;
    } else {
        PG8_STAGE(PG8_SB(0, 0), cB, voffB); PG8_STAGE(PG8_SA(0, 0), cA, voffA); PG8_STAGE(PG8_SB(0, 1), cB + hstep, voffB); PG8_STAGE(PG8_SA(0, 1), cA + hstep, voffA);
        if (wr == 1) PG8_BAR;
        PG8_WAIT_V(4); PG8_BAR;
        PG8_STAGE(PG8_SB(1, 0), cB + kstep, voffB); PG8_STAGE(PG8_SA(1, 0), cA + kstep, voffA); PG8_STAGE(PG8_SB(1, 1), cB + hstep + kstep, voffB);
        PG8_WAIT_V(6); PG8_BAR;
    }
    for (;;) {
        const bool has_next = S.next(ui + 1, nxt);
        const char* nA = has_next ? (const char*)g.A + (size_t)nxt.pm * tstep : cA; const char* nB = has_next ? (const char*)g.Bt + (size_t)nxt.pn * tstep : cB;
        for (int t = 0; t < nt; t += 2) {
            const bool last = (t == nt - 2);
            const char* a1 = cA + (size_t)(t + 1) * kstep;
            const char* a2 = last ? nA : cA + (size_t)(t + 2) * kstep; const char* b2 = last ? nB : cB + (size_t)(t + 2) * kstep;
            const char* a3 = a2 + kstep; const char* b3 = b2 + kstep;
            if (last && has_next) S.a_ready(nxt);
            if constexpr (SP2) {
            PG8_LDB(B0, 0, 0); PG8_LDB(B1, 0, 1); PG8_SCHED; PG8_LDA(At, 0, 0); PG8_STAGE(PG8_SA(1, 1), a1 + hstep, voffA);
            PG8_WAIT_V(8); PG8_WAIT_L(0); PG8_BAR; PG8_MMA(0, 0, At, B0); PG8_MMA(0, 1, At, B1); PG8_BAR; PG8_SCHED;
            PG8_LDA(At, 0, 1); PG8_STAGE(PG8_SB(0, 0), b2, voffB); PG8_STAGE(PG8_SB(0, 1), b2 + hstep, voffB); PG8_STAGE(PG8_SA(0, 0), a2, voffA);
            PG8_WAIT_V(8); PG8_WAIT_L(0); PG8_BAR; PG8_MMA(1, 0, At, B0); PG8_MMA(1, 1, At, B1); PG8_BAR; PG8_SCHED;
            PG8_LDB(B0, 1, 0); PG8_LDB(B1, 1, 1); PG8_SCHED; PG8_LDA(At, 1, 0); PG8_STAGE(PG8_SA(0, 1), a2 + hstep, voffA);
            PG8_WAIT_V(8); PG8_WAIT_L(0); PG8_BAR; PG8_MMA(0, 0, At, B0); PG8_MMA(0, 1, At, B1); PG8_BAR; PG8_SCHED;
            PG8_LDA(At, 1, 1); PG8_STAGE(PG8_SB(1, 0), b3, voffB); PG8_STAGE(PG8_SB(1, 1), b3 + hstep, voffB); PG8_STAGE(PG8_SA(1, 0), a3, voffA);
            PG8_WAIT_V(8); PG8_WAIT_L(0); PG8_BAR; PG8_MMA(1, 0, At, B0); PG8_MMA(1, 1, At, B1); PG8_BAR; PG8_SCHED;
            } else {
            PG8_LDB(B0, 0, 0); PG8_SCHED; PG8_LDA(At, 0, 0); PG8_STAGE(PG8_SA(1, 1), a1 + hstep, voffA);
            PG8_WAIT_L(8); PG8_BAR; PG8_WAIT_L(0); PG8_MMA(0, 0, At, B0); PG8_BAR; PG8_SCHED;
            PG8_LDB(B1, 0, 1); PG8_STAGE(PG8_SB(0, 0), b2, voffB);
            PG8_BAR; PG8_WAIT_L(0); PG8_MMA(0, 1, At, B1); PG8_BAR;
            PG8_LDA(At, 0, 1); PG8_STAGE(PG8_SA(0, 0), a2, voffA);
            PG8_BAR; PG8_WAIT_L(0); PG8_MMA(1, 0, At, B0); PG8_BAR; PG8_SCHED;
            PG8_STAGE(PG8_SB(0, 1), b2 + hstep, voffB);
            PG8_WAIT_V(6); PG8_BAR; PG8_MMA(1, 1, At, B1); PG8_BAR;
            PG8_LDB(B0, 1, 0); PG8_SCHED; PG8_LDA(At, 1, 0); PG8_STAGE(PG8_SA(0, 1), a2 + hstep, voffA);
            PG8_WAIT_L(8); PG8_BAR; PG8_WAIT_L(0); PG8_MMA(0, 0, At, B0); PG8_BAR; PG8_SCHED;
            PG8_LDB(B1, 1, 1); PG8_STAGE(PG8_SB(1, 0), b3, voffB);
            PG8_BAR; PG8_WAIT_L(0); PG8_MMA(0, 1, At, B1); PG8_BAR;
            PG8_LDA(At, 1, 1); PG8_STAGE(PG8_SA(1, 0), a3, voffA);
            PG8_BAR; PG8_WAIT_L(0); PG8_MMA(1, 0, At, B0); PG8_BAR; PG8_SCHED;
            PG8_STAGE(PG8_SB(1, 1), b3 + hstep, voffB);
            PG8_WAIT_V(6); PG8_BAR; PG8_MMA(1, 1, At, B1); PG8_BAR;
            }
        }
        if constexpr (ALIGN_EPI) { if (wr == 0) PG8_BAR; }
        if constexpr (!Epi::AFTER_DRAIN) { E(acc, cur, wr, wc, fr, fq); S.done(cur); }
        if (!has_next) break;
#pragma unroll
        for (int a = 0; a < 2; ++a)
#pragma unroll
            for (int b = 0; b < 2; ++b)
#pragma unroll
                for (int m = 0; m < 4; ++m)
#pragma unroll
                    for (int n = 0; n < 2; ++n) acc[a][b][m][n] = (f32x4){0.f, 0.f, 0.f, 0.f};
        cur = nxt; cA = nA; cB = nB; ++ui;
        if constexpr (ALIGN_EPI) { if (wr == 1) PG8_BAR; }
    }
    PG8_WAIT_V(0);
    if constexpr (!ALIGN_EPI) { if (wr == 0) PG8_BAR; }
    PG8_BAR;
    if constexpr (Epi::AFTER_DRAIN) { E.fused(acc, cur, wr, wc, fr, fq, lds, wid, lane); S.done(cur); }
#undef PG8_SA
#undef PG8_SB
#undef PG8_STAGE
#undef PG8_LDA
#undef PG8_LDB
#undef PG8_MMA
#undef PG8_WAIT_V
#undef PG8_WAIT_L
#undef PG8_BAR
#undef PG8_SCHED
}
}

#include <hip/hip_bf16.h>
#include <cmath>
namespace attn_body {
using bf16=__hip_bfloat16;
using bf16x8=__attribute__((ext_vector_type(8)))short;
using s16x4=__attribute__((ext_vector_type(4)))short;
using f32x16=__attribute__((ext_vector_type(16)))float;
using u32x4=__attribute__((ext_vector_type(4)))unsigned;
constexpr int BATCH=2,NHEAD=16,SEQ=8192,D=64,DM=NHEAD*D;
constexpr int NW=8,QBLK=32,QB=QBLK*NW,KVBLK=64,NQB=SEQ/QB;
constexpr int ATTN_PITCH=DM, ATTN_UNIT_ROWS=QB;
__device__ __forceinline__ int crow(int r,int hi){return (r&3)+8*(r>>2)+4*hi;}
#define SBAR() __builtin_amdgcn_sched_barrier(0)
__device__ __forceinline__ void cmask(f32x16&p0,f32x16&p1,int jb,int qrel,int hi){
  const float NEG=-INFINITY; int kb=64*jb+4*hi;
  #pragma unroll
  for(int r=0;r<16;++r){int kv=kb+(r&3)+8*(r>>2); if(kv>qrel)p0[r]=NEG; if(kv+32>qrel)p1[r]=NEG;}
}

constexpr int NSLOT=3, SLOTB=8192;
constexpr int LDS_K=0, LDS_V=NSLOT*SLOTB, LDS_WS=2*NSLOT*SLOTB, LDS_OST=LDS_WS+NW*64*4, LDS_BYTES=LDS_OST+NW*4096, LDS_CK=LDS_BYTES, LDS_MISC=LDS_CK+32768, LDS_TOTAL=LDS_MISC+64+256;
constexpr float C2=0.125f*1.4426950408889634f;
__device__ __forceinline__ void glds16(const void*gsrc,unsigned lds_dst){unsigned keep;
  asm volatile("s_mov_b32 %0, m0\n\ts_mov_b32 m0, %2\n\ts_nop 0\n\tglobal_load_lds_dwordx4 %1, off\n\ts_mov_b32 m0, %0":"=&s"(keep):"v"(gsrc),"s"(lds_dst):"memory");}
__device__ __forceinline__ float max3f(float a,float b,float c){float r;asm("v_max3_f32 %0, %1, %2, %3":"=v"(r):"v"(a),"v"(b),"v"(c));return r;}
__device__ __forceinline__ float max2f(float a,float b){float r;asm("v_max_f32_e32 %0, %1, %2":"=v"(r):"v"(a),"v"(b));return r;}
__device__ __forceinline__ float fadd_s(float a,float b){float r;asm("v_add_f32_e32 %0, %1, %2":"=v"(r):"v"(a),"v"(b));return r;}
__device__ __forceinline__ float fsub_s(float a,float b){float r;asm("v_sub_f32_e32 %0, %1, %2":"=v"(r):"v"(a),"v"(b));return r;}
typedef float f32x2_t __attribute__((ext_vector_type(2))); typedef __bf16 bf16x2_t __attribute__((ext_vector_type(2)));
__device__ __forceinline__ unsigned cvtpk_s(float lo,float hi){f32x2_t v={lo,hi};bf16x2_t b=__builtin_convertvector(v,bf16x2_t);return __builtin_bit_cast(unsigned,b);}
#define WAIT_BAR(N) asm volatile("s_waitcnt vmcnt(" #N ") lgkmcnt(0)\n\ts_barrier":::"memory")

__device__ __forceinline__ void qkt(f32x16&p0,f32x16&p1,const char*Kslot,const bf16x8*qr,const f32x16&negm,int r32,int hi){
  const char*kb=Kslot+hi*1024+r32*16;
  #pragma unroll
  for(int d0=0;d0<4;++d0){
    const bf16x8 b0=*reinterpret_cast<const bf16x8*>(kb+d0*2048);
    const bf16x8 b1=*reinterpret_cast<const bf16x8*>(kb+d0*2048+512);
    if(d0==0){p0=__builtin_amdgcn_mfma_f32_32x32x16_bf16(b0,qr[0],negm,0,0,0);p1=__builtin_amdgcn_mfma_f32_32x32x16_bf16(b1,qr[0],negm,0,0,0);}
    else{p0=__builtin_amdgcn_mfma_f32_32x32x16_bf16(b0,qr[d0],p0,0,0,0);p1=__builtin_amdgcn_mfma_f32_32x32x16_bf16(b1,qr[d0],p1,0,0,0);}}
}
typedef __attribute__((address_space(3))) const char* lds_cptr;
typedef short v4i16_t __attribute__((ext_vector_type(4)));
__device__ __forceinline__ void kload8(bf16x8*kf,lds_cptr kp){
  kf[0]=*(const __attribute__((address_space(3))) bf16x8*)(kp);      kf[1]=*(const __attribute__((address_space(3))) bf16x8*)(kp+512);
  kf[2]=*(const __attribute__((address_space(3))) bf16x8*)(kp+2048); kf[3]=*(const __attribute__((address_space(3))) bf16x8*)(kp+2560);
  kf[4]=*(const __attribute__((address_space(3))) bf16x8*)(kp+4096); kf[5]=*(const __attribute__((address_space(3))) bf16x8*)(kp+4608);
  kf[6]=*(const __attribute__((address_space(3))) bf16x8*)(kp+6144); kf[7]=*(const __attribute__((address_space(3))) bf16x8*)(kp+6656);
}
__device__ __forceinline__ void kload2(bf16x8*kf,lds_cptr kp,int j){ kf[2*j]=*(const __attribute__((address_space(3))) bf16x8*)(kp+j*2048); kf[2*j+1]=*(const __attribute__((address_space(3))) bf16x8*)(kp+j*2048+512); }
__device__ __forceinline__ s16x4 vtr(lds_cptr p){ return __builtin_bit_cast(s16x4,__builtin_amdgcn_ds_read_tr16_b64_v4i16((__attribute__((address_space(3))) v4i16_t*)p)); }
__device__ __forceinline__ float rowmax(const f32x16&p0,const f32x16&p1){
  float a=max3f(p0[0],p0[1],p1[0]),b=max3f(p0[2],p0[3],p1[1]);a=max3f(a,p1[2],p1[3]);
  #pragma unroll
  for(int r=4;r<16;r+=4){a=max3f(a,p0[r],p0[r+1]);b=max3f(b,p0[r+2],p0[r+3]);a=max3f(a,p1[r],p1[r+1]);b=max3f(b,p1[r+2],p1[r+3]);}
  const float m=max2f(a,b);
  auto rr=__builtin_amdgcn_permlane32_swap(__float_as_uint(m),__float_as_uint(m),false,false);
  return max2f(__uint_as_float(rr[0]),__uint_as_float(rr[1]));
}
__device__ __forceinline__ void pv(f32x16*o,int vb,bf16x8 pa0,bf16x8 pa1,bf16x8 pa2,bf16x8 pa3){
  #pragma unroll
  for(int d0=0;d0<2;++d0){s16x4 lo[4],hi[4];
    #pragma unroll
    for(int ks=0;ks<4;++ks){
      asm volatile("ds_read_b64_tr_b16 %0,%1 offset:%c2":"=&v"(lo[ks]):"v"(vb),"i"(d0*4096+ks*1024):"memory");
      asm volatile("ds_read_b64_tr_b16 %0,%1 offset:%c2":"=&v"(hi[ks]):"v"(vb),"i"(d0*4096+ks*1024+512):"memory");}
    asm volatile("s_waitcnt lgkmcnt(0)":::"memory");SBAR();
    #define PK(k) (bf16x8){lo[k][0],lo[k][1],lo[k][2],lo[k][3],hi[k][0],hi[k][1],hi[k][2],hi[k][3]}
    o[d0]=__builtin_amdgcn_mfma_f32_32x32x16_bf16(pa0,PK(0),o[d0],0,0,0);
    o[d0]=__builtin_amdgcn_mfma_f32_32x32x16_bf16(pa1,PK(1),o[d0],0,0,0);
    o[d0]=__builtin_amdgcn_mfma_f32_32x32x16_bf16(pa2,PK(2),o[d0],0,0,0);
    o[d0]=__builtin_amdgcn_mfma_f32_32x32x16_bf16(pa3,PK(3),o[d0],0,0,0);
    #undef PK
  }
}

#ifndef ATTN_STORE16
#define ATTN_STORE16(p,v) (*(u32x4*)(p)=(v))
#endif
template<int THRL> __device__ __forceinline__ void attn_unit(int b,int h,int qb,int t0,float cqv,float mfix,const float*__restrict__ cf,float cref,unsigned*counter,const bf16*Q,const bf16*__restrict__ K,const bf16*__restrict__ V,bf16*O,const bf16*__restrict__ G,char*shm){
  int tid=threadIdx.x; asm volatile("":"+v"(tid)); const int lane=tid&63,r32=lane&31,hi=lane>>5; const int wid=__builtin_amdgcn_readfirstlane(tid>>6);
  const long rowbase=(long)b*SEQ; const int q0=qb*QB;
  const bf16*Qw=Q+(rowbase+q0+wid*QBLK)*DM+h*D;
  const bf16*Kh=K+(rowbase+(long)t0*KVBLK)*DM+h*D,*Vh=V+(rowbase+(long)t0*KVBLK)*DM+h*D;
  const unsigned lds0=(unsigned)(uintptr_t)shm;
  float*wsf=(float*)(shm+LDS_WS)+wid*64;
  const bf16*ksrc=Kh+(long)lane*DM+wid*8;
  const bf16*vsrc=Vh+(long)(16*(wid&3)+(lane>>2))*DM+(wid>>2)*32+(lane&3)*8;
  const unsigned kdst=lds0+LDS_K+wid*1024, vdst=lds0+LDS_V+wid*1024;
  #define DMA_K(t,slot) glds16(ksrc+(long)(t)*KVBLK*DM,(unsigned)__builtin_amdgcn_readfirstlane(kdst+(slot)))
  #define DMA_V(t,slot) glds16(vsrc+(long)(t)*KVBLK*DM,(unsigned)__builtin_amdgcn_readfirstlane(vdst+(slot)))
  const int vb0=(int)(lds0+LDS_V)+((lane>>4)&1)*32+(lane&3)*8+(4*hi+((lane&15)>>2))*64;
  const char*Kbase=shm+LDS_K; bf16x8 kf[8];
  const lds_cptr shm3=(lds_cptr)shm; const lds_cptr kp0=shm3+LDS_K+hi*1024+r32*16; const lds_cptr vp0=shm3+LDS_V+((lane>>4)&1)*32+(lane&3)*8+(4*hi+((lane&15)>>2))*64;
  const int NT=(q0+QB)/KVBLK-t0;
  DMA_K(0,0);DMA_V(0,0);DMA_K(1,SLOTB);
  { __attribute__((address_space(3))) float* CK=(__attribute__((address_space(3))) float*)((__attribute__((address_space(3))) char*)shm+LDS_CK);
    for(int base=t0*64+tid;base<q0+QB;base+=4*NW*64){ float cv[4];
      #pragma unroll
      for(int j=0;j<4;++j){ const int idx=base+NW*64*j; cv[j]=(idx<q0+QB)?cf[idx]:0.f; }
      #pragma unroll
      for(int j=0;j<4;++j){ const int idx=base+NW*64*j; if(idx<q0+QB) CK[idx]=(cv[j]-cref)*1.4426950408889634f; } } }
  bf16x8 qr[4];
  #pragma unroll
  for(int d0=0;d0<4;++d0)qr[d0]=*reinterpret_cast<const bf16x8*>(&Qw[(long)r32*DM+d0*16+hi*8]);
  float mhat=mfix,l_reg=0.f;f32x16 o[2];o[0]=f32x16{};o[1]=f32x16{};const f32x16 negm=f32x16{};
  const int qrel=wid*QBLK+r32;
  #define CMASK(P0,P1,t) do{int jb_=(t)-(NT-4); if(jb_>=0)cmask(P0,P1,jb_,qrel,hi);}while(0)
  typedef float f32x4_t __attribute__((ext_vector_type(4)));
  #define BIAS(P0,P1,t) do{ const __attribute__((address_space(3))) f32x4_t* ckp_=(const __attribute__((address_space(3))) f32x4_t*)(shm3+LDS_CK+((t)+t0)*256+hi*16); \
    const float cm_=cqv-mhat; _Pragma("unroll") for(int j_=0;j_<4;++j_){ const f32x4_t a_=ckp_[2*j_], b_=ckp_[2*j_+8]; \
      _Pragma("unroll") for(int i_=0;i_<4;++i_){ P0[4*j_+i_]+=cm_-a_[i_]; P1[4*j_+i_]+=cm_-b_[i_]; } } }while(0)
  bool resc=false;
  #define START(P0,P1) do{ resc=false; \
    _Pragma("unroll") for(int r=0;r<16;++r)P0[r]=__builtin_amdgcn_exp2f(P0[r]); }while(0)
  #define RESC() do{}while(0)
  f32x16 pA0,pA1,pB0,pB1;
  int sl_prev=0,sl_cur=0,sl_next=SLOTB;
  #define ROT() do{sl_prev=sl_cur;sl_cur=sl_next;sl_next=(sl_next==(NSLOT-1)*SLOTB)?0:sl_next+SLOTB;}while(0)
  DMA_K(2,2*SLOTB);
  WAIT_BAR(3);
  qkt(pA0,pA1,Kbase,qr,negm,r32,hi);asm volatile("s_nop 15\n\ts_nop 7":"+v"(pA0),"+v"(pA1));BIAS(pA0,pA1,0);CMASK(pA0,pA1,0);
  START(pA0,pA1);
  _Pragma("unroll") for(int r=0;r<16;++r)pA1[r]=__builtin_amdgcn_exp2f(pA1[r]);
  WAIT_BAR(0);
  DMA_K(3,0);DMA_V(1,SLOTB);
  ROT();
  kload8(kf,kp0+sl_cur);
  WAIT_BAR(2);
  s16x4 vlo[8],vhi[8]; u32x4 pw0,pw1,pw2,pw3;
  #define PKW(P,B) cvtpk_s(P[B],P[B+1])
  #define PAF(k) __builtin_bit_cast(bf16x8,pw##k)
  #define VFR(i) (bf16x8){vlo[i][0],vlo[i][1],vlo[i][2],vlo[i][3],vhi[i][0],vhi[i][1],vhi[i][2],vhi[i][3]}
  #define PIN(x) asm volatile("":"+v"(x))
  #define MX3(a,b,c) __builtin_fmaxf(__builtin_fmaxf((a),(b)),(c))
  #define GAPA(MF,A0,A1,A2,A3,W0,W1,PW) do{ MF; sacc+=A0; sacc+=A1; sacc+=A2; sacc+=A3; PIN(sacc); W0; W1; PIN(PW); SBAR(); }while(0)
  #define EX(v) __builtin_amdgcn_exp2f(v)
  #define GAPB(MF,X,B) do{ MF; X[B]=EX(X[B]); X[B+1]=EX(X[B+1]); X[B+2]=EX(X[B+2]); X[B+3]=EX(X[B+3]); PIN(X); SBAR(); }while(0)
  #define VRD(i) do{ vlo[i]=vtr(vp_+(((i)>>2)*4096+((i)&3)*1024)); vhi[i]=vtr(vp_+(((i)>>2)*4096+((i)&3)*1024+512)); }while(0)
  #define KRD(G,j) do{ if(G){ kload2(kf,kp0+sl_next,j); SBAR(); } }while(0)
  #define STEP(C0,C1,P0,P1,t,GK,GV,GL) do{ SBAR(); \
    const lds_cptr vp_=vp0+sl_prev; \
    VRD(0); SBAR(); float sacc=(P0[0]+P0[1]); \
    GAPA(C0=__builtin_amdgcn_mfma_f32_32x32x16_bf16(kf[0],qr[0],negm,0,0,0), P0[2],P0[3],P0[4],P0[5],     pw0[0]=PKW(P0,0), pw0[1]=PKW(P0,2), pw0); \
    VRD(4); SBAR(); GAPA(C1=__builtin_amdgcn_mfma_f32_32x32x16_bf16(kf[1],qr[0],negm,0,0,0), P0[6],P0[7],P0[8],P0[9],     pw0[2]=PKW(P0,4), pw0[3]=PKW(P0,6), pw0); \
    VRD(1); SBAR(); GAPA(C0=__builtin_amdgcn_mfma_f32_32x32x16_bf16(kf[2],qr[1],C0,0,0,0),   P0[10],P0[11],P0[12],P0[13], pw1[0]=PKW(P0,8), pw1[1]=PKW(P0,10), pw1); \
    VRD(5); SBAR(); GAPA(C1=__builtin_amdgcn_mfma_f32_32x32x16_bf16(kf[3],qr[1],C1,0,0,0),   P0[14],P0[15],P1[0],P1[1],   pw1[2]=PKW(P0,12),pw1[3]=PKW(P0,14), pw1); \
    VRD(2); SBAR(); GAPA(C0=__builtin_amdgcn_mfma_f32_32x32x16_bf16(kf[4],qr[2],C0,0,0,0),   P1[2],P1[3],P1[4],P1[5],     pw2[0]=PKW(P1,0), pw2[1]=PKW(P1,2), pw2); \
    VRD(6); SBAR(); GAPA(C1=__builtin_amdgcn_mfma_f32_32x32x16_bf16(kf[5],qr[2],C1,0,0,0),   P1[6],P1[7],P1[8],P1[9],     pw2[2]=PKW(P1,4), pw2[3]=PKW(P1,6), pw2); \
    VRD(3); SBAR(); GAPA(C0=__builtin_amdgcn_mfma_f32_32x32x16_bf16(kf[6],qr[3],C0,0,0,0),   P1[10],P1[11],P1[12],P1[13], pw3[0]=PKW(P1,8), pw3[1]=PKW(P1,10), pw3); \
    VRD(7); SBAR(); GAPA(C1=__builtin_amdgcn_mfma_f32_32x32x16_bf16(kf[7],qr[3],C1,0,0,0),   P1[14],P1[15],0.f,0.f,       pw3[2]=PKW(P1,12),pw3[3]=PKW(P1,14), pw3); \
    l_reg+=sacc; \
    if(GK){DMA_K((t)+3,sl_cur);} if(GV){DMA_V((t)+1,sl_next);} \
    BIAS(C0,C1,t); CMASK(C0,C1,t); \
    SBAR(); \
    GAPB(o[0]=__builtin_amdgcn_mfma_f32_32x32x16_bf16(PAF(0),VFR(0),o[0],0,0,0), C0,0); \
    GAPB(o[1]=__builtin_amdgcn_mfma_f32_32x32x16_bf16(PAF(0),VFR(4),o[1],0,0,0), C0,4); \
    KRD(GL,0); GAPB(o[0]=__builtin_amdgcn_mfma_f32_32x32x16_bf16(PAF(1),VFR(1),o[0],0,0,0), C0,8); \
    KRD(GL,1); GAPB(o[1]=__builtin_amdgcn_mfma_f32_32x32x16_bf16(PAF(1),VFR(5),o[1],0,0,0), C0,12); \
    KRD(GL,2); GAPB(o[0]=__builtin_amdgcn_mfma_f32_32x32x16_bf16(PAF(2),VFR(2),o[0],0,0,0), C1,0); \
    KRD(GL,3); GAPB(o[1]=__builtin_amdgcn_mfma_f32_32x32x16_bf16(PAF(2),VFR(6),o[1],0,0,0), C1,4); \
    GAPB(o[0]=__builtin_amdgcn_mfma_f32_32x32x16_bf16(PAF(3),VFR(3),o[0],0,0,0), C1,8); \
    GAPB(o[1]=__builtin_amdgcn_mfma_f32_32x32x16_bf16(PAF(3),VFR(7),o[1],0,0,0), C1,12); \
    }while(0)
  int t=1;
  #undef CMASK
  #define CMASK(P0,P1,t) do{}while(0)
  for(;t+5<NT;t+=2){
    STEP(pB0,pB1,pA0,pA1,t,true,true,true);     WAIT_BAR(2); RESC(); ROT();
    STEP(pA0,pA1,pB0,pB1,t+1,true,true,true);   WAIT_BAR(2); RESC(); ROT();
  }
  #undef CMASK
  #define CMASK(P0,P1,t) do{int jb_=(t)-(NT-4); if(jb_>=0)cmask(P0,P1,jb_,qrel,hi);}while(0)
  #define ENDW(tt) do{ if((tt)+3<NT){WAIT_BAR(2);} else if((tt)+2<NT){WAIT_BAR(1);} else {WAIT_BAR(0);} }while(0)
  for(;t+1<NT;t+=2){
    STEP(pB0,pB1,pA0,pA1,t,(t+3<NT),(t+1<NT),(t+1<NT));       ENDW(t);   RESC(); ROT();
    STEP(pA0,pA1,pB0,pB1,t+1,(t+4<NT),(t+2<NT),(t+2<NT));     ENDW(t+1); RESC(); ROT();
  }
  STEP(pB0,pB1,pA0,pA1,NT-1,false,false,false); RESC();
  { float sacc=pB0[0]+pB0[1]; _Pragma("unroll") for(int r=2;r<16;++r)sacc+=pB0[r]; _Pragma("unroll") for(int r=0;r<16;++r)sacc+=pB1[r]; l_reg+=sacc;
    pw0=(u32x4){PKW(pB0,0),PKW(pB0,2),PKW(pB0,4),PKW(pB0,6)};pw1=(u32x4){PKW(pB0,8),PKW(pB0,10),PKW(pB0,12),PKW(pB0,14)};pw2=(u32x4){PKW(pB1,0),PKW(pB1,2),PKW(pB1,4),PKW(pB1,6)};pw3=(u32x4){PKW(pB1,8),PKW(pB1,10),PKW(pB1,12),PKW(pB1,14)};
    SBAR(); pv(o,vb0+sl_cur,PAF(0),PAF(1),PAF(2),PAF(3)); }
  #undef PKW
  #undef PAF
  #undef VFR
  #undef PIN
  #undef MX3
  #undef GAPA
  #undef GAPB
  #undef EX
  #undef VRD
  #undef KRD
  #undef STEP
  #undef ENDW
  int unext_=0; if(tid==0) unext_=(int)atomicAdd(counter,1u);
  {auto rr=__builtin_amdgcn_permlane32_swap(__float_as_uint(l_reg),__float_as_uint(l_reg),false,false);l_reg=__uint_as_float(rr[0])+__uint_as_float(rr[1]);}
  if(hi==0)wsf[32+r32]=l_reg;asm volatile("s_waitcnt lgkmcnt(0)":::"memory");
  float rli[16];
  #pragma unroll
  for(int r=0;r<16;++r)rli[r]=__builtin_amdgcn_rcpf(wsf[32+crow(r,hi)]);
  bf16*Ow=O+(rowbase+q0+wid*QBLK)*DM+h*D;
  { bf16*stg=(bf16*)(shm+LDS_OST)+wid*2048;
    #pragma unroll
    for(int r=0;r<16;++r){const int orow=crow(r,hi);
      #pragma unroll
      for(int d0=0;d0<2;++d0)stg[orow*64+d0*32+r32]=__float2bfloat16(o[d0][r]*rli[r]);}
    asm volatile("s_waitcnt lgkmcnt(0)":::"memory");
    const bf16*Gw=G+(rowbase+q0+wid*QBLK)*DM+h*D;
    u32x4 gv4[4];
    #pragma unroll
    for(int i=0;i<4;++i)gv4[i]=*(const u32x4*)(Gw+(long)(i*8+(lane>>3))*DM+(lane&7)*8);
    #pragma unroll
    for(int i=0;i<4;++i){const int row=i*8+(lane>>3),ch=lane&7; const u32x4 v=*(const u32x4*)(stg+row*64+ch*8); const u32x4 gv=gv4[i]; u32x4 w;
      #pragma unroll
      for(int c=0;c<4;++c){ const float ol=__uint_as_float(v[c]<<16), oh=__uint_as_float(v[c]&0xffff0000u), gl=__uint_as_float(gv[c]<<16), gh=__uint_as_float(gv[c]&0xffff0000u);
        const float rl=ol*gl*__builtin_amdgcn_rcpf(1.f+__expf(-gl)), rh=oh*gh*__builtin_amdgcn_rcpf(1.f+__expf(-gh)); w[c]=cvtpk_s(rl,rh); }
      ATTN_STORE16(Ow+(long)row*DM+ch*8,w);} }
  if(tid==0) *(volatile __attribute__((address_space(3))) int*)((__attribute__((address_space(3))) char*)shm+LDS_MISC)=unext_;
  asm volatile("s_waitcnt lgkmcnt(0)\n\ts_barrier":::"memory");
  #undef DMA_K
  #undef DMA_V
  #undef CMASK
  #undef START
  #undef RESC
  #undef ROT
  #undef BIAS
}

template<int THRL> __device__ __forceinline__ void fox_attn_phase(char*lds,const bf16*Q,const bf16*K,const bf16*V,bf16*O,const bf16*G,const float*__restrict__ cumf,unsigned*counter,float TH,float mfix){
  const int tid=threadIdx.x,lane=tid&63; const int wid=__builtin_amdgcn_readfirstlane(tid>>6);
  if(wid>=4) __builtin_amdgcn_s_setprio(1);
  volatile __attribute__((address_space(3))) int* shi=(volatile __attribute__((address_space(3))) int*)((__attribute__((address_space(3))) char*)lds+LDS_MISC);
  volatile __attribute__((address_space(3))) int* Wb=shi+16; volatile __attribute__((address_space(3))) int* sorted=shi+48;
  { const int nbr=4*(NQB-1);
    int u0_=0; if(tid==0) u0_=(int)atomicAdd(counter,1u);
    float cr_[4],ea_[4],eb_[4];
    #pragma unroll
    for(int hh=0;hh<4;++hh){ const float* cfr=cumf+(long)(wid*4+hh)*SEQ; cr_[hh]=cfr[(NQB-1)*QB]; ea_[hh]=(lane<nbr)?cfr[64*lane+63]:0.f; eb_[hh]=(lane+64<nbr)?cfr[64*(lane+64)+63]:0.f; }
    #pragma unroll
    for(int hh=0;hh<4;++hh){ const int bhh=wid*4+hh;
      bool k0=true,k1=true; if(lane<nbr) k0=(cr_[hh]-ea_[hh])>=-TH; if(lane+64<nbr) k1=(cr_[hh]-eb_[hh])>=-TH;
      const unsigned long long m0=__ballot(k0), m1=__ballot(k1);
      int first=m0?__builtin_ctzll(m0):(m1?64+__builtin_ctzll(m1):128); if(first>nbr)first=nbr;
      if(lane==0) Wb[bhh]=nbr-first; }
    if(tid==0) shi[0]=u0_;
    __syncthreads();
    if(wid==0){ const int myW=(lane<32)?Wb[lane]:-1; int rank=0;
      for(int j=0;j<32;++j){ const int wj=Wb[j]; rank+=((wj>myW)||(wj==myW&&j<lane))?1:0; }
      if(lane<32) sorted[rank]=lane; }
    __syncthreads(); }
  for(;;){
    const int u=shi[0];
    if(u>=NQB*BATCH*NHEAD) break;
    const int qb=NQB-1-(u&31), bh=sorted[u>>5], q0=qb*QB;
    const float* cf=cumf+(long)bh*SEQ;
    const float cref=cf[q0];
    const int nb=4*qb; float e0=0.f,e1=0.f;
    if(lane<nb) e0=cf[64*lane+63];
    if(lane+64<nb) e1=cf[64*(lane+64)+63];
    const float cqr=cf[q0+wid*QBLK+(lane&31)];
    int t0;
    { bool k0=true,k1=true;
      if(lane<nb) k0=(cref-e0)>=-TH;
      if(lane+64<nb) k1=(cref-e1)>=-TH;
      const unsigned long long m0=__ballot(k0), m1=__ballot(k1);
      int first=m0?__builtin_ctzll(m0):(m1?64+__builtin_ctzll(m1):128); if(first>nb)first=nb;
      t0=__builtin_amdgcn_readfirstlane(first&~1); }
    const float cqv=(cqr-cref)*1.4426950408889634f;
    attn_unit<THRL>(bh/NHEAD,bh%NHEAD,qb,t0,cqv,mfix,cf,cref,counter,Q,K,V,O,G,lds);
  }
  __builtin_amdgcn_s_setprio(0);
}
#undef SBAR
#undef WAIT_BAR
}

#include <hip/hip_cooperative_groups.h>
namespace cg = cooperative_groups;
#define LAS __attribute__((address_space(3)))
typedef unsigned short bf16;
typedef unsigned v4u __attribute__((ext_vector_type(4)));
typedef unsigned v2u __attribute__((ext_vector_type(2)));
typedef float f32x4 __attribute__((ext_vector_type(4)));
typedef short bf16x8 __attribute__((ext_vector_type(8)));
typedef short v4i16_t __attribute__((ext_vector_type(4)));
constexpr int NWAVES = 8, NTHR = 512;
constexpr int M = 16384, D = 1024, SEQL = 8192;
constexpr int N0 = 3072, N1 = 4096, N1L = 4112;
constexpr float EPSN = 1e-6f;
constexpr size_t MiB = 1u << 20;
constexpr size_t WS_CTL = 0, WS_ROWSS = 65536, WS_MOD = 131072, CTL_ZERO_BYTES = 196608;
constexpr int CW_BAR = 4096;
__device__ __forceinline__ unsigned char* ws_ctl_base(unsigned char* ws) { return ws + WS_CTL; }
constexpr size_t WS_BIAS1 = 1 * MiB + 256 * 1024;
constexpr size_t WS_W0IN = 2 * MiB, WS_W0OUT = 8 * MiB, WS_W1IN = 10 * MiB, WS_W1OUT = 19 * MiB, WS_POOLW = 21 * MiB;
constexpr size_t WS_LOGF = 22 * MiB, WS_CUMF = 23 * MiB;
constexpr size_t WS_H = 24 * MiB;
constexpr size_t WS_P0 = 56 * MiB;
constexpr size_t WS_MIX = 152 * MiB;
constexpr size_t WS_LST = 184 * MiB, WS_SST = 200 * MiB, WS_DTOT = 216 * MiB;
constexpr size_t WS_END = 217 * MiB;
constexpr int LDS_BYTES = 147456;

typedef float f32x2_t __attribute__((ext_vector_type(2))); typedef __bf16 bf16x2_t __attribute__((ext_vector_type(2)));
__device__ __forceinline__ unsigned pk2(float lo, float hi) { f32x2_t v = {lo, hi}; bf16x2_t b = __builtin_convertvector(v, bf16x2_t); return __builtin_bit_cast(unsigned, b); }
__device__ __forceinline__ unsigned f2bf(float f) { return pk2(f, 0.f) & 0xffffu; }
__device__ __forceinline__ float bf2f(unsigned short h) { return __uint_as_float((unsigned)h << 16); }
__device__ __forceinline__ float bflo(unsigned w) { return __uint_as_float(w << 16); }
__device__ __forceinline__ float bfhi(unsigned w) { return __uint_as_float(w & 0xffff0000u); }
__device__ __forceinline__ float sigmf(float x) { return __builtin_amdgcn_rcpf(1.f + __builtin_amdgcn_exp2f(x * -1.4426950408889634f)); }
__device__ __forceinline__ float siluf(float x) { return x * sigmf(x); }
__device__ __forceinline__ float wave_sum(float v) {
#pragma unroll
    for (int o = 1; o < 64; o <<= 1) v += __shfl_xor(v, o);
    return v;
}
__device__ __forceinline__ bf16x8 trfrag(const LAS char* p, int hioff) {
    const v4i16_t lo = __builtin_amdgcn_ds_read_tr16_b64_v4i16((LAS v4i16_t*)p);
    const v4i16_t hi = __builtin_amdgcn_ds_read_tr16_b64_v4i16((LAS v4i16_t*)(p + hioff));
    return (bf16x8){lo[0], lo[1], lo[2], lo[3], hi[0], hi[1], hi[2], hi[3]};
}

__device__ __forceinline__ void transpose_item(const float* W, int K, int N, bf16* WT, int prow0, int k0, int n0, LAS float* scr, int lane) {
    float tv[32];
#pragma unroll
    for (int i = 0; i < 32; ++i) { const int kk = 2 * i + (lane >> 5), c = n0 + (lane & 31); tv[i] = (c < N) ? W[(size_t)(k0 + kk) * N + c] : 0.f; }
#pragma unroll
    for (int i = 0; i < 32; ++i) { const int kk = 2 * i + (lane >> 5); scr[kk * 33 + (lane & 31)] = tv[i]; }
    asm volatile("s_waitcnt lgkmcnt(0)" ::: "memory");
    const int c = lane & 7;
#pragma unroll
    for (int j = 0; j < 4; ++j) { const int n = (lane >> 3) + 8 * j; const LAS float* s = scr + (8 * c) * 33 + n;
        v4u o; o.x = pk2(s[0 * 33], s[1 * 33]); o.y = pk2(s[2 * 33], s[3 * 33]); o.z = pk2(s[4 * 33], s[5 * 33]); o.w = pk2(s[6 * 33], s[7 * 33]);
        *(v4u*)(WT + (size_t)(prow0 + n) * K + k0 + 8 * c) = o; }
    asm volatile("s_waitcnt lgkmcnt(0)" ::: "memory");
}

struct Args { const float* in[16]; float* out; unsigned char* ws; };

__device__ __forceinline__ void weight_copy_items(const Args& a, LAS unsigned char* lds, int lo, int hi, int G) {
    int tid = threadIdx.x; asm volatile("" : "+v"(tid)); const int lane = tid & 63, wave = tid >> 6;
    unsigned char* ws = a.ws;
    LAS float* scr = (LAS float*)(lds + wave * 16384);
    constexpr int I0 = 16 * 96, I4 = 4 * 2 * 4, I1 = 16 * 32, I2 = 16 * 129, I3 = 16 * 32;
    for (int it = lo + (int)blockIdx.x * NWAVES + wave; it < hi; it += G * NWAVES) {
        int r = it;
        if (r < I0) { const int kb = r / 96, nb = r % 96; transpose_item(a.in[6], D, N0, (bf16*)(ws + WS_W0IN), 32 * nb, 64 * kb, 32 * nb, scr, lane); continue; } r -= I0;
        if (r < I4) { const int gi = r >> 3, kb = (r >> 2) & 1, nb = r & 3; transpose_item(a.in[8] + (size_t)gi * 128 * 128, 128, 128, (bf16*)(ws + WS_POOLW) + (size_t)gi * 128 * 128, 32 * nb, 64 * kb, 32 * nb, scr, lane); continue; } r -= I4;
        if (r < I1) { const int kb = r / 32, nb = r % 32; transpose_item(a.in[10], D, D, (bf16*)(ws + WS_W0OUT), 32 * nb, 64 * kb, 32 * nb, scr, lane); continue; } r -= I1;
        if (r < I2) { const int kb = r / 129, lg = r % 129; const int pg = lg < 128 ? (8 * (lg >> 3) + 4 * (lg & 1) + ((lg & 7) >> 1)) : 128;
            transpose_item(a.in[11], D, N1L, (bf16*)(ws + WS_W1IN), 32 * pg, 64 * kb, 32 * lg, scr, lane); continue; } r -= I2;
        { const int kb = r / 32, nb = r % 32; transpose_item(a.in[15], D, D, (bf16*)(ws + WS_W1OUT), 32 * nb, 64 * kb, 32 * nb, scr, lane); }
    }
}

__device__ __forceinline__ void prologue_phase(const Args& a, LAS unsigned char* lds, int G) {
    int tid = threadIdx.x; asm volatile("" : "+v"(tid)); const int lane = tid & 63, wave = tid >> 6;
    unsigned char* ws = a.ws;
    {
        const float* cvec = a.in[1]; const float* ada_w = a.in[3]; const float* ada_b = a.in[4]; float* mod = (float*)(ws + WS_MOD);
        LAS float* red = (LAS float*)(lds + 131072);
        for (int it = blockIdx.x; it < 192; it += G) {
            const int half = it / 96, r = it % 96, l = r / 48, cgp = r % 48, col = cgp * 64 + lane, kb = half * 512 + wave * 64;
            const float* wp = ada_w + (size_t)l * D * 3072 + (size_t)kb * 3072 + col;
            float wv[64];
#pragma unroll
            for (int k = 0; k < 64; ++k) wv[k] = wp[(size_t)k * 3072];
            float a0 = 0.f, a1 = 0.f;
#pragma unroll
            for (int k = 0; k < 64; ++k) { const float c0 = cvec[kb + k], c1 = cvec[D + kb + k]; a0 += siluf(c0) * wv[k]; a1 += siluf(c1) * wv[k]; }
            red[(wave * 2 + 0) * 64 + lane] = a0; red[(wave * 2 + 1) * 64 + lane] = a1;
            __syncthreads();
            if (wave < 2) { float s = half == 0 ? ada_b[l * 3072 + col] : 0.f;
#pragma unroll
                for (int w = 0; w < 8; ++w) s += red[(w * 2 + wave) * 64 + lane];
                atomicAdd(mod + (l * 2 + wave) * 3072 + col, s); }
            __syncthreads();
        }
    }
    weight_copy_items(a, lds, 0, 16 * 96 + 32, G);
}

__device__ __forceinline__ void norm_mod_phase(const float* X, const float* ng, const float* mod, bf16* H, int G) {
    int tid = threadIdx.x; asm volatile("" : "+v"(tid)); const int lane = tid & 63, wave = tid >> 6;
    const int gw = blockIdx.x * NWAVES + wave, NGW = G * NWAVES;
#pragma unroll 1
    for (int b = 0; b < 2; ++b) {
        f32x4 gs[4], sh[4];
#pragma unroll
        for (int j = 0; j < 4; ++j) { const int c = 4 * lane + 256 * j; gs[j] = *(const f32x4*)(ng + c) * (*(const f32x4*)(mod + b * 3072 + 1024 + c) + 1.0f); sh[j] = *(const f32x4*)(mod + b * 3072 + c); }
        for (int tb = gw; tb < SEQL; tb += 4 * NGW) {
            f32x4 v[4][4]; float s[4]; int mr[4]; bool has[4];
#pragma unroll
            for (int r = 0; r < 4; ++r) { const int t = tb + r * NGW; has[r] = t < SEQL; mr[r] = b * SEQL + (has[r] ? t : tb); const f32x4* xr = (const f32x4*)(X + (size_t)mr[r] * D) + lane;
#pragma unroll
                for (int j = 0; j < 4; ++j) v[r][j] = xr[64 * j]; }
#pragma unroll
            for (int r = 0; r < 4; ++r) { float q = 0.f;
#pragma unroll
                for (int j = 0; j < 4; ++j) q += (v[r][j].x * v[r][j].x + v[r][j].y * v[r][j].y) + (v[r][j].z * v[r][j].z + v[r][j].w * v[r][j].w);
                s[r] = q; }
#pragma unroll
            for (int o = 1; o < 64; o <<= 1) {
#pragma unroll
                for (int r = 0; r < 4; ++r) s[r] += __shfl_xor(s[r], o); }
#pragma unroll
            for (int r = 0; r < 4; ++r) { if (!has[r]) continue;
                const float rs = __builtin_amdgcn_rsqf(s[r] * (1.f / D) + EPSN); v2u* o8 = (v2u*)(H + (size_t)mr[r] * D) + lane;
#pragma unroll
                for (int j = 0; j < 4; ++j) { const f32x4 h = v[r][j] * rs * gs[j] + sh[j]; o8[64 * j] = (v2u){pk2(h.x, h.y), pk2(h.z, h.w)}; } }
        }
    }
}

constexpr int RS = 272;
template <int W> __device__ __forceinline__ void pool_fill(LAS unsigned char* Al, const LAS unsigned char* Ul, int tid, int tt0) {
    const int t = tid >> 2, cq = tid & 3; const int tt = tt0 + t; const int cnt = tt + 1 < W ? tt + 1 : W;
    const float inv = 1.0f / (float)cnt;
#pragma unroll
    for (int ch = 0; ch < 4; ++ch) {
        float acc[8];
#pragma unroll
        for (int e = 0; e < 8; ++e) acc[e] = 0.f;
        v4u self = (v4u){0u, 0u, 0u, 0u};
#pragma unroll
        for (int j = 0; j < W; ++j) { const v4u x = *(const LAS v4u*)(Ul + (t + 15 - j) * RS + (cq * 32 + ch * 8) * 2); if (j == 0) self = x;
#pragma unroll
            for (int e = 0; e < 4; ++e) { acc[2 * e] += bflo(x[e]); acc[2 * e + 1] += bfhi(x[e]); } }
        v4u o;
#pragma unroll
        for (int e = 0; e < 4; ++e) o[e] = pk2(acc[2 * e] * inv - bflo(self[e]), acc[2 * e + 1] * inv - bfhi(self[e]));
        *(LAS v4u*)(Al + t * RS + (cq * 32 + ch * 8) * 2) = o;
    }
}
__device__ __forceinline__ void pool_unit(LAS unsigned char* lds, int unit, const bf16* P0, const bf16* PWt, const float* pscale, bf16* MIX) {
    int tid = threadIdx.x; asm volatile("" : "+v"(tid)); const int lane = tid & 63, wave = tid >> 6, li = lane & 15, g = lane >> 4;
    const int grp = unit < 256 ? (unit & 3) : 3 - (unit & 3), rt = unit >> 2, row0 = rt * 128, tt0 = row0 & 8191;
    LAS unsigned char* Al = lds; LAS unsigned char* Bl = lds + 128 * RS; LAS unsigned char* Ul = lds + 256 * RS;
    {
        const bf16* src = PWt + (size_t)grp * 16384;
        v4u bw[4], uw[5];
#pragma unroll
        for (int j = 0; j < 4; ++j) { const int i = tid + NTHR * j, d = i >> 4, c16 = i & 15; bw[j] = *(const v4u*)(src + d * 128 + c16 * 8); }
#pragma unroll
        for (int j = 0; j < 5; ++j) { const int i = tid + NTHR * j, r = i >> 4, c16 = i & 15; const int tt = tt0 - 15 + r;
            uw[j] = (v4u){0u, 0u, 0u, 0u};
            if (i < 143 * 16 && tt >= 0) uw[j] = *(const v4u*)(P0 + (size_t)(row0 - 15 + r) * N0 + 2048 + grp * 128 + c16 * 8); }
#pragma unroll
        for (int j = 0; j < 4; ++j) { const int i = tid + NTHR * j, d = i >> 4, c16 = i & 15; *(LAS v4u*)(Bl + d * RS + c16 * 16) = bw[j]; }
#pragma unroll
        for (int j = 0; j < 5; ++j) { const int i = tid + NTHR * j, r = i >> 4, c16 = i & 15; if (i < 143 * 16) *(LAS v4u*)(Ul + r * RS + c16 * 16) = uw[j]; }
    }
    __syncthreads();
    if (grp == 0) pool_fill<2>(Al, Ul, tid, tt0); else if (grp == 1) pool_fill<4>(Al, Ul, tid, tt0); else if (grp == 2) pool_fill<8>(Al, Ul, tid, tt0); else pool_fill<16>(Al, Ul, tid, tt0);
    __syncthreads();
    f32x4 acc[8];
#pragma unroll
    for (int db = 0; db < 8; ++db) acc[db] = (f32x4){0.f, 0.f, 0.f, 0.f};
#pragma unroll
    for (int ks = 0; ks < 4; ++ks) {
        const bf16x8 y = *(const LAS bf16x8*)(Al + (16 * wave + li) * RS + (32 * ks + 8 * g) * 2);
#pragma unroll
        for (int db = 0; db < 8; ++db) { const bf16x8 x = *(const LAS bf16x8*)(Bl + (16 * db + li) * RS + (32 * ks + 8 * g) * 2);
            acc[db] = __builtin_amdgcn_mfma_f32_16x16x32_bf16(x, y, acc[db], 0, 0, 0); }
    }
    const int row = row0 + 16 * wave + li;
    v2u gbv[8]; f32x4 psv[8];
#pragma unroll
    for (int db = 0; db < 8; ++db) { const int dcol = grp * 128 + 16 * db + 4 * g; gbv[db] = *(const v2u*)(P0 + (size_t)row * N0 + 2560 + dcol); psv[db] = *(const f32x4*)(pscale + dcol); }
#pragma unroll
    for (int db = 0; db < 8; ++db) { const int dcol = grp * 128 + 16 * db + 4 * g;
        const v2u gb = gbv[db]; const f32x4 ps = psv[db];
        const float o0 = acc[db][0] * ps[0] * siluf(bflo(gb[0])), o1 = acc[db][1] * ps[1] * siluf(bfhi(gb[0])), o2 = acc[db][2] * ps[2] * siluf(bflo(gb[1])), o3 = acc[db][3] * ps[3] * siluf(bfhi(gb[1]));
        *(v2u*)(MIX + (size_t)row * D + 512 + dcol) = (v2u){pk2(o0, o1), pk2(o2, o3)}; }
    __syncthreads();
}

constexpr int HL_V = 0, HL_QT = 8704, HL_KT = 17408, HL_KE = 26112, HL_SC = 36352, HL_TOT = 38912, HL_DEC = 40960, HL_OUT = 41472, HL_S = 58368;
template <bool PC> __device__ __forceinline__ void hgrn_unit(LAS unsigned char* lds, int unit, const bf16* P0, const float* lbp, const float* ong, float* Lst, const float* Sst, float* Dtot, bf16* MIX) {
    int tid = threadIdx.x; asm volatile("" : "+v"(tid)); const int lane = tid & 63, wave = tid >> 6, li = lane & 15, g = lane >> 4, q4 = li >> 2, p4 = li & 3;
    if (__builtin_amdgcn_readfirstlane(wave) >= 4) __builtin_amdgcn_s_setprio(1);
    const int b = unit >> 7, hd = (unit >> 5) & 3, sc = unit & 31;
    const int row0 = b * SEQL + sc * 256;
    const int k = 16 * wave + li, tq = g;
    float lb;
    { const float a0 = lbp[hd * 128 + k], a1 = lbp[512 + hd * 128 + k], a2 = lbp[1024 + hd * 128 + k]; const float mx = fmaxf(a0, fmaxf(a1, a2));
      const float e0 = __expf(a0 - mx), e1 = __expf(a1 - mx), e2 = __expf(a2 - mx); lb = e0 / (e0 + e1 + e2); }
    f32x4 S[8];
    if (PC) {
#pragma unroll
        for (int kb = 0; kb < 8; ++kb) { S[kb] = *(const f32x4*)(Sst + (size_t)unit * 16384 + (16 * kb + li) * 128 + 16 * wave + 4 * g);
            *(LAS v2u*)(lds + HL_S + (16 * kb + li) * RS + (16 * wave + 4 * g) * 2) = (v2u){pk2(S[kb][0], S[kb][1]), pk2(S[kb][2], S[kb][3])}; }
    } else {
#pragma unroll
        for (int kb = 0; kb < 8; ++kb) S[kb] = (f32x4){0.f, 0.f, 0.f, 0.f};
    }
    float sumlog = 0.f;
    f32x4 g0 = (f32x4){0.f, 0.f, 0.f, 0.f}, g1 = g0; if (PC) { g0 = *(const f32x4*)(ong + hd * 128 + 8 * (tid & 15)); g1 = *(const f32x4*)(ong + hd * 128 + 8 * (tid & 15) + 4); }
    LAS float* DEC = (LAS float*)(lds + HL_DEC);
    unsigned nf[8], nq[8]; v4u nv, ng = (v4u){0u, 0u, 0u, 0u};
#define HG_LOAD(step_) do { const int r0_ = row0 + (step_) * 32; const bf16* fp_ = P0 + (size_t)(r0_ + 8 * tq) * N0 + 512 + hd * 128 + k; \
        _Pragma("unroll") for (int t_ = 0; t_ < 8; ++t_) { nf[t_] = fp_[(size_t)t_ * N0]; if (PC) nq[t_] = fp_[(size_t)t_ * N0 - 512]; } \
        nv = *(const v4u*)(P0 + (size_t)(r0_ + (tid >> 4)) * N0 + 1024 + hd * 128 + (tid & 15) * 8); \
        if (PC) ng = *(const v4u*)(P0 + (size_t)(r0_ + (tid >> 4)) * N0 + 1536 + hd * 128 + (tid & 15) * 8); } while (0)
#define HB() asm volatile("s_waitcnt lgkmcnt(0)\n\ts_barrier" ::: "memory")
    HG_LOAD(0);
#pragma unroll 1
    for (int step = 0; step < 8; ++step) {
        const int r0 = row0 + step * 32;
        float lf[8], ky[8], qv[8];
        {
#pragma unroll
          for (int t = 0; t < 8; ++t) { const float f = __uint_as_float(nf[t] << 16); const float sg = sigmf(f); const float fg = lb + (1.f - lb) * sg; lf[t] = __builtin_amdgcn_logf(fg); ky[t] = 1.f - fg;
              if (PC) qv[t] = __uint_as_float(nq[t] << 16); }
        }
        const v4u cv = nv, ga = ng;
        if (step < 7) HG_LOAD(step + 1);
#pragma unroll
        for (int t = 1; t < 8; ++t) lf[t] += lf[t - 1];
        { const int s = tid >> 4, c16 = tid & 15; *(LAS v4u*)(lds + HL_V + s * RS + c16 * 16) = cv; }
        float pre, cl;
        { const float T = lf[7]; const float p1 = __shfl_up(T, 16), p2 = __shfl_up(T, 32), p3 = __shfl_up(T, 48);
          pre = (tq >= 1 ? p1 : 0.f) + (tq >= 2 ? p2 : 0.f) + (tq >= 3 ? p3 : 0.f);
          const float s2 = T + __shfl_xor(T, 16); cl = s2 + __shfl_xor(s2, 32); }
        const float ecl = __builtin_amdgcn_exp2f(cl);
        { unsigned kw[4];
#pragma unroll
          for (int t = 0; t < 8; t += 2) { const float c0 = pre + lf[t], c1 = pre + lf[t + 1];
              const float k0 = ky[t] * __builtin_amdgcn_exp2f(-c0), k1 = ky[t + 1] * __builtin_amdgcn_exp2f(-c1);
              kw[t >> 1] = pk2(k0 * ecl, k1 * ecl);
              if (PC) { const unsigned kk = pk2(k0, k1), qq = pk2(qv[t] * __builtin_amdgcn_exp2f(c0), qv[t + 1] * __builtin_amdgcn_exp2f(c1));
                  *(LAS unsigned short*)(lds + HL_KT + (8 * tq + t) * RS + k * 2) = (unsigned short)(kk & 0xffffu);
                  *(LAS unsigned short*)(lds + HL_KT + (8 * tq + t + 1) * RS + k * 2) = (unsigned short)(kk >> 16);
                  *(LAS unsigned short*)(lds + HL_QT + (8 * tq + t) * RS + k * 2) = (unsigned short)(qq & 0xffffu);
                  *(LAS unsigned short*)(lds + HL_QT + (8 * tq + t + 1) * RS + k * 2) = (unsigned short)(qq >> 16); } }
          *(LAS v4u*)(lds + HL_KE + k * 80 + tq * 16) = (v4u){kw[0], kw[1], kw[2], kw[3]}; }
        if (tq == 0) DEC[k] = ecl;
        sumlog += cl;
        HB();
        if (PC) {
            if (wave < 4) {
                const int ti = wave >> 1, si = wave & 1;
                f32x4 a = (f32x4){0.f, 0.f, 0.f, 0.f};
                if (si <= ti) {
#pragma unroll
                    for (int ks = 0; ks < 4; ++ks) { const bf16x8 x = *(const LAS bf16x8*)(lds + HL_KT + (16 * si + li) * RS + (32 * ks + 8 * g) * 2);
                        const bf16x8 y = *(const LAS bf16x8*)(lds + HL_QT + (16 * ti + li) * RS + (32 * ks + 8 * g) * 2);
                        a = __builtin_amdgcn_mfma_f32_16x16x32_bf16(x, y, a, 0, 0, 0); }
                    if (si == ti) {
#pragma unroll
                        for (int r = 0; r < 4; ++r) if (4 * g + r > li) a[r] = 0.f;
                    }
                }
                *(LAS v2u*)(lds + HL_SC + (16 * ti + li) * 80 + (16 * si + 4 * g) * 2) = (v2u){pk2(a[0], a[1]), pk2(a[2], a[3])};
            }
            HB();
        }
        const bf16x8 xv = trfrag((const LAS char*)(lds + HL_V + (8 * g + q4) * RS + (16 * wave + 4 * p4) * 2), 4 * RS);
        bf16x8 xs[4], yq[2][4], ysc[2], yk[8]; float dcv[8];
        if (PC) {
#pragma unroll
            for (int tb = 0; tb < 2; ++tb) ysc[tb] = *(const LAS bf16x8*)(lds + HL_SC + (16 * tb + li) * 80 + g * 16);
#pragma unroll
            for (int ks = 0; ks < 4; ++ks) { xs[ks] = trfrag((const LAS char*)(lds + HL_S + (32 * ks + 8 * g + q4) * RS + (16 * wave + 4 * p4) * 2), 4 * RS);
#pragma unroll
                for (int tb = 0; tb < 2; ++tb) yq[tb][ks] = *(const LAS bf16x8*)(lds + HL_QT + (16 * tb + li) * RS + (32 * ks + 8 * g) * 2); }
        }
#pragma unroll
        for (int kb = 0; kb < 8; ++kb) { dcv[kb] = DEC[16 * kb + li]; yk[kb] = *(const LAS bf16x8*)(lds + HL_KE + (16 * kb + li) * 80 + g * 16); }
        __builtin_amdgcn_sched_barrier(0);
        if (PC) {
            f32x4 o[2];
#pragma unroll
            for (int tb = 0; tb < 2; ++tb) o[tb] = __builtin_amdgcn_mfma_f32_16x16x32_bf16(xv, ysc[tb], (f32x4){0.f, 0.f, 0.f, 0.f}, 0, 0, 0);
#pragma unroll
            for (int ks = 0; ks < 4; ++ks)
#pragma unroll
                for (int tb = 0; tb < 2; ++tb) o[tb] = __builtin_amdgcn_mfma_f32_16x16x32_bf16(xs[ks], yq[tb][ks], o[tb], 0, 0, 0);
#pragma unroll
            for (int tb = 0; tb < 2; ++tb) *(LAS f32x4*)(lds + HL_OUT + ((16 * tb + li) * 132 + 16 * wave + 4 * g) * 4) = o[tb];
        }
#pragma unroll
        for (int kb = 0; kb < 8; ++kb) S[kb] = __builtin_amdgcn_mfma_f32_16x16x32_bf16(xv, yk[kb], S[kb] * dcv[kb], 0, 0, 0);
        HB();
        if (PC) {
#pragma unroll
            for (int kb = 0; kb < 8; ++kb) *(LAS v2u*)(lds + HL_S + (16 * kb + li) * RS + (16 * wave + 4 * g) * 2) = (v2u){pk2(S[kb][0], S[kb][1]), pk2(S[kb][2], S[kb][3])};
            const int t = tid >> 4, vg = tid & 15;
            const f32x4 o0 = *(const LAS f32x4*)(lds + HL_OUT + (t * 132 + 8 * vg) * 4), o1 = *(const LAS f32x4*)(lds + HL_OUT + (t * 132 + 8 * vg + 4) * 4);
            float ss = (o0[0] * o0[0] + o0[1] * o0[1]) + (o0[2] * o0[2] + o0[3] * o0[3]) + (o1[0] * o1[0] + o1[1] * o1[1]) + (o1[2] * o1[2] + o1[3] * o1[3]);
            ss += __shfl_xor(ss, 1); ss += __shfl_xor(ss, 2); ss += __shfl_xor(ss, 4); ss += __shfl_xor(ss, 8);
            const float rstd = __builtin_amdgcn_rsqf(ss * (1.f / 128.f) + EPSN);
            const int col = hd * 128 + 8 * vg;
            v4u w;
            w[0] = pk2(o0[0] * rstd * g0[0] * siluf(bflo(ga[0])), o0[1] * rstd * g0[1] * siluf(bfhi(ga[0])));
            w[1] = pk2(o0[2] * rstd * g0[2] * siluf(bflo(ga[1])), o0[3] * rstd * g0[3] * siluf(bfhi(ga[1])));
            w[2] = pk2(o1[0] * rstd * g1[0] * siluf(bflo(ga[2])), o1[1] * rstd * g1[1] * siluf(bfhi(ga[2])));
            w[3] = pk2(o1[2] * rstd * g1[2] * siluf(bflo(ga[3])), o1[3] * rstd * g1[3] * siluf(bfhi(ga[3])));
            *(v4u*)(MIX + (size_t)(r0 + t) * D + col) = w;
        }
    }
    if (!PC) {
#pragma unroll
        for (int kb = 0; kb < 8; ++kb) *(f32x4*)(Lst + (size_t)unit * 16384 + (16 * kb + li) * 128 + 16 * wave + 4 * g) = S[kb];
        if (tq == 0) Dtot[unit * 128 + k] = __builtin_amdgcn_exp2f(sumlog);
    }
    __builtin_amdgcn_s_setprio(0);
    __syncthreads();
#undef HG_LOAD
#undef HB
}

__device__ __forceinline__ void hgrn_scan_phase(const float* __restrict__ Lst, const float* __restrict__ Dtot, float* __restrict__ Sst, int G) {
    int tid = threadIdx.x; asm volatile("" : "+v"(tid));
    for (int e = blockIdx.x * NTHR + tid; e < 8 * 16384; e += G * NTHR) {
        const int bh = e >> 14, kv = e & 16383, kk = kv >> 7;
        float s = 0.f;
#pragma unroll 8
        for (int sc = 0; sc < 32; ++sc) { const size_t u = (size_t)(bh * 32 + sc);
            Sst[u * 16384 + kv] = s;
            s = Dtot[u * 128 + kk] * s + Lst[u * 16384 + kv]; }
    }
}

__device__ __forceinline__ void bias1_phase(const bf16* W1t, const float* mod1, float* biasp, int G) {
    int tid = threadIdx.x; asm volatile("" : "+v"(tid)); const int lane = tid & 63, wave = tid >> 6;
    for (int p = blockIdx.x * NWAVES + wave; p < 4112; p += G * NWAVES) {
        float s0 = 0.f, s1 = 0.f;
#pragma unroll
        for (int j = 0; j < 2; ++j) { const int k0 = 8 * lane + 512 * j; const v4u w = *(const v4u*)(W1t + (size_t)p * D + k0);
#pragma unroll
            for (int e = 0; e < 4; ++e) { const float wl = bflo(w[e]), wh = bfhi(w[e]);
                s0 += wl * mod1[k0 + 2 * e] + wh * mod1[k0 + 2 * e + 1]; s1 += wl * mod1[3072 + k0 + 2 * e] + wh * mod1[3072 + k0 + 2 * e + 1]; } }
        s0 = wave_sum(s0); s1 = wave_sum(s1);
        if (lane == 0) { biasp[p] = s0; biasp[4352 + p] = s1; }
    }
}

__device__ __forceinline__ void fl_phase(const bf16* H, const bf16* Wfl, const float* bfv, const float* rowss, const float* biasp, float* logf, int G) {
    int tid = threadIdx.x; asm volatile("" : "+v"(tid)); const int lane = tid & 63, wave = tid >> 6, li = lane & 15, g = lane >> 4;
    for (int rb = blockIdx.x + G * wave; rb < M / 16; rb += G * NWAVES) {
        const bf16* ap = H + (size_t)(16 * rb + li) * D + 8 * g; const bf16* bp = Wfl + (size_t)li * D + 8 * g;
        f32x4 acc = (f32x4){0.f, 0.f, 0.f, 0.f};
#pragma unroll 8
        for (int ks = 0; ks < 32; ++ks) { const bf16x8 a = *(const bf16x8*)(ap + 32 * ks), b = *(const bf16x8*)(bp + 32 * ks);
            acc = __builtin_amdgcn_mfma_f32_16x16x32_bf16(a, b, acc, 0, 0, 0); }
        const int row = 16 * rb + 4 * g, bb = row >> 13, t = row & 8191; const float bias = bfv[li] + biasp[bb * 4352 + 4096 + li];
        const f32x4 rq = *(const f32x4*)(rowss + row);
        f32x4 o;
#pragma unroll
        for (int r = 0; r < 4; ++r) { const float z = acc[r] * __builtin_amdgcn_rsqf(rq[r] * (1.0f / 1024.0f) + EPSN) + bias; o[r] = fminf(z, 0.f) - log1pf(__expf(-fabsf(z))); }
        *(f32x4*)(logf + (size_t)(bb * 16 + li) * SEQL + t) = o;
    }
}

__device__ __forceinline__ void cumf_phase(LAS unsigned char* lds, const float* logf, float* cumf, int G) {
    int tid = threadIdx.x; asm volatile("" : "+v"(tid)); const int lane = tid & 63, wave = tid >> 6;
    LAS float* wt = (LAS float*)lds;
    for (int bh = blockIdx.x; bh < 32; bh += G) {
        const f32x4* src = (const f32x4*)(logf + (size_t)bh * SEQL + 16 * tid);
        f32x4 v[4]; float run = 0.f;
#pragma unroll
        for (int j = 0; j < 4; ++j) { v[j] = src[j]; v[j].x += run; v[j].y += v[j].x; v[j].z += v[j].y; v[j].w += v[j].z; run = v[j].w; }
        float inc = run;
#pragma unroll
        for (int o = 1; o < 64; o <<= 1) { const float n = __shfl_up(inc, o); if (lane >= o) inc += n; }
        if (lane == 63) wt[wave] = inc;
        __syncthreads();
        float base = inc - run;
        for (int w = 0; w < wave; ++w) base += wt[w];
        f32x4* dst = (f32x4*)(cumf + (size_t)bh * SEQL + 16 * tid);
#pragma unroll
        for (int j = 0; j < 4; ++j) dst[j] = v[j] + base;
        __syncthreads();
    }
}

#define GAS __attribute__((address_space(1)))
#define RLX_AGENT __ATOMIC_RELAXED, __HIP_MEMORY_SCOPE_AGENT
#define XB_TMO      128
#define XB_XCNT(j)  (256  + 64 * (j))
#define XB_XSUB(j)  (1280 + 64 * (j))
#define XB_XGEN(j)  (2304 + 64 * (j))
#define XB_TOP      3328
#define XB_TOPGEN   3392
#define XCD_BAR_WORDS 3456
#define XB_SPIN_CAP (1u << 18)

__device__ __forceinline__ unsigned xb_ld(unsigned* p)              { return __hip_atomic_load(p, __ATOMIC_RELAXED, __HIP_MEMORY_SCOPE_AGENT); }
__device__ __forceinline__ unsigned xb_add(unsigned* p, unsigned v) { return __hip_atomic_fetch_add(p, v, __ATOMIC_RELAXED, __HIP_MEMORY_SCOPE_AGENT); }
__device__ __forceinline__ unsigned xb_xcc_id() { return (unsigned)__builtin_amdgcn_s_getreg((3 << 11) | 20) & 0xFu; }
#define XB_SPIN(cond, bar) do { unsigned _sp = 0; while (cond) { __builtin_amdgcn_s_sleep(1); \
    if ((++_sp & 255u) == 0u) { if (xb_ld(&(bar)[XB_TMO])) break; if (_sp > XB_SPIN_CAP) { atomicAdd(&(bar)[XB_TMO], 1u); break; } } } } while (0)

struct XcdBarrier {
    unsigned* bar; unsigned x;
    volatile LAS unsigned* st;
};

__device__ __forceinline__ XcdBarrier xcd_barrier_post(unsigned* bar, volatile LAS unsigned* st) {
    XcdBarrier b; b.bar = bar; b.x = xb_xcc_id(); b.st = st;
    if (threadIdx.x == 0) (void)xb_add(&bar[XB_XCNT(b.x)], 1u);
    return b;
}
__device__ __forceinline__ void xcd_barrier_complete(unsigned* bar, unsigned x, unsigned& nloc, unsigned& nx) {
    const unsigned G = gridDim.x * gridDim.y * gridDim.z;
    unsigned sum, cnt, mine, sp = 0u;
    for (;;) {
        sum = 0u; cnt = 0u; mine = 0u;
#pragma unroll
        for (unsigned j = 0; j < 16; ++j) { const unsigned c = xb_ld(&bar[XB_XCNT(j)]); sum += c; cnt += (c > 0u) ? 1u : 0u; mine = (j == x) ? c : mine; }
        if (sum == G) break;
        __builtin_amdgcn_s_sleep(1);
        if ((++sp & 255u) == 0u) { if (xb_ld(&bar[XB_TMO])) break; if (sp > XB_SPIN_CAP) { atomicAdd(&bar[XB_TMO], 1u); break; } }
    }
    nloc = mine > 0u ? mine : 1u; nx = cnt > 0u ? cnt : 1u;
}

__device__ __forceinline__ void xcd_barrier(const XcdBarrier& b) {
    asm volatile("s_waitcnt vmcnt(0)" ::: "memory");
    __syncthreads();
    if (threadIdx.x == 0) {
        unsigned* bar = b.bar;
        __builtin_amdgcn_s_waitcnt(0);
        unsigned nloc = b.st[0], nx = b.st[1];
        if (nloc == 0u) { xcd_barrier_complete(bar, b.x, nloc, nx); b.st[0] = nloc; b.st[1] = nx; }
        const unsigned old = xb_add(&bar[XB_XSUB(b.x)], 1u);
        const unsigned gen = old / nloc;
        if (old + 1u == (gen + 1u) * nloc) {
            __builtin_amdgcn_fence(__ATOMIC_RELEASE, "agent");
            asm volatile("s_waitcnt vmcnt(0)" ::: "memory");
            const unsigned og = xb_add(&bar[XB_TOP], 1u);
            const unsigned tg = og / nx;
            if (og + 1u == (tg + 1u) * nx) xb_add(&bar[XB_TOPGEN], 1u);
            else XB_SPIN(xb_ld(&bar[XB_TOPGEN]) == tg, bar);
            __builtin_amdgcn_fence(__ATOMIC_ACQUIRE, "agent");
            xb_add(&bar[XB_XGEN(b.x)], 1u);
            asm volatile("s_waitcnt vmcnt(0)" ::: "memory");
        } else {
            XB_SPIN(xb_ld(&bar[XB_XGEN(b.x)]) == gen, bar);
            __builtin_amdgcn_fence(__ATOMIC_ACQUIRE, "agent");
            asm volatile("s_waitcnt vmcnt(0)" ::: "memory");
        }
    }
    __syncthreads();
}

__global__ void __launch_bounds__(NTHR, 2) fwd_megakernel(Args args) {
    extern __shared__ __attribute__((aligned(16))) unsigned char lds_raw[];
    LAS unsigned char* lds = (LAS unsigned char*)lds_raw;
    cg::grid_group grid = cg::this_grid();
    if (gridDim.x == 0x7fffffffu) grid.sync();
    { volatile LAS unsigned* mz = (volatile LAS unsigned*)(lds + LDS_BYTES - 64); if (threadIdx.x < 16) mz[threadIdx.x] = 0u; }
    __syncthreads();
    XcdBarrier xbar = xcd_barrier_post((unsigned*)(ws_ctl_base(args.ws)) + CW_BAR, (volatile LAS unsigned*)(lds + LDS_BYTES - 64));
#ifdef PROBE_DUP_SYNC
#define GSYNC() do { xcd_barrier(xbar); xcd_barrier(xbar); } while (0)
#else
#define GSYNC() xcd_barrier(xbar)
#endif
#ifndef PROBE_MASK
#define PROBE_MASK 0
#endif
#define REP(p) for (int rep_ = 0; rep_ < (((PROBE_MASK >> (p)) & 1) ? 2 : 1); ++rep_)
    const int G = gridDim.x;
    unsigned char* ws = args.ws;
    const float* x = args.in[0];
    float* out = args.out;
    float* mod = (float*)(ws + WS_MOD);
    bf16* H = (bf16*)(ws + WS_H); bf16* P0 = (bf16*)(ws + WS_P0); bf16* MIX = (bf16*)(ws + WS_MIX);
    unsigned* ctl = (unsigned*)(ws + WS_CTL);

    REP(0) { prologue_phase(args, lds, G);
    GSYNC(); }
    REP(1) { norm_mod_phase(x, args.in[2], mod, H, G);
    GSYNC(); }
    REP(2) { pg8::Gemm g{H, (const bf16*)(ws + WS_W0IN), M, N0, D}; pg8::StaticOrder S; S.init(M, N0, G, (int)blockIdx.x);
      pg8::EpiBf16<0> E{P0, N0, nullptr, 0, 0, 1.f};
      pg8::gemm_phase<pg8::EpiBf16<0>, pg8::StaticOrder, true, true>(lds, g, S, E);
    GSYNC(); }
    REP(3) {
    for (int u = blockIdx.x; u < 256; u += G) hgrn_unit<false>(lds, u, P0, args.in[5], args.in[7], (float*)(ws + WS_LST), nullptr, (float*)(ws + WS_DTOT), MIX);
    for (int u = blockIdx.x; u < 512; u += G) pool_unit(lds, u, P0, (const bf16*)(ws + WS_POOLW), args.in[9], MIX);
    weight_copy_items(args, lds, 16 * 96 + 32, 16 * 96 + 32 + 16 * 32 + 16 * 129 + 16 * 32, G);
    GSYNC(); }
    REP(4) { hgrn_scan_phase((const float*)(ws + WS_LST), (const float*)(ws + WS_DTOT), (float*)(ws + WS_SST), G);
    GSYNC(); }
    REP(5) { for (int u = blockIdx.x; u < 256; u += G) hgrn_unit<true>(lds, u, P0, args.in[5], args.in[7], nullptr, (const float*)(ws + WS_SST), nullptr, MIX);
    bias1_phase((const bf16*)(ws + WS_W1IN), mod + 2 * 3072, (float*)(ws + WS_BIAS1), G);
    GSYNC(); }
    REP(6) { pg8::Gemm g{MIX, (const bf16*)(ws + WS_W0OUT), M, D, D}; pg8::StaticOrder S; S.init(M, D, G, (int)blockIdx.x);
      pg8::EpiResid<true> E{3072, out, x, mod + 2048, args.in[2] + D, mod + 2 * 3072 + 1024, H, (float*)(ws + WS_ROWSS)};
      pg8::gemm_phase<pg8::EpiResid<true>, pg8::StaticOrder, true, true>(lds, g, S, E);
    GSYNC(); }
    REP(8) {
        fl_phase(H, (const bf16*)(ws + WS_W1IN) + (size_t)4096 * D, args.in[12], (const float*)(ws + WS_ROWSS), (const float*)(ws + WS_BIAS1), (float*)(ws + WS_LOGF), G);
      pg8::Gemm g{H, (const bf16*)(ws + WS_W1IN), M, N1, D}; pg8::StaticOrder S; S.init(M, N1, G, (int)blockIdx.x);
      pg8::EpiOdd E{attn_body::C2, P0, args.in[13], args.in[14], (const float*)(ws + WS_BIAS1), (const float*)(ws + WS_ROWSS)};
      pg8::gemm_phase<pg8::EpiOdd, pg8::StaticOrder, true, true>(lds, g, S, E);
    GSYNC(); }
    REP(9) { cumf_phase(lds, (const float*)(ws + WS_LOGF), (float*)(ws + WS_CUMF), G);
    GSYNC(); }
    REP(10) {
        float mq = 0.f, mk = 0.f;
        { int tid = threadIdx.x; asm volatile("" : "+v"(tid)); const int lane = tid & 63; mq = fabsf(args.in[13][lane]); mk = fabsf(args.in[14][lane]);
#pragma unroll
          for (int o = 1; o < 64; o <<= 1) { mq = fmaxf(mq, __shfl_xor(mq, o)); mk = fmaxf(mk, __shfl_xor(mk, o)); } }
        const float TH = 30.f + 2.f * 8.f * mq * mk * 1.01f;
        const attn_body::bf16* Qb = (const attn_body::bf16*)P0;
        attn_body::fox_attn_phase<8>((char*)lds_raw, Qb, Qb + (size_t)M * D, Qb + 2 * (size_t)M * D, (attn_body::bf16*)H, (const attn_body::bf16*)MIX,
                                     (const float*)(ws + WS_CUMF), ctl + 64 + 64 * rep_, TH, 8.f * mq * mk * 1.01f * 1.4426950408889634f);
    GSYNC(); }
    { pg8::Gemm g{H, (const bf16*)(ws + WS_W1OUT), M, D, D}; pg8::StaticOrder S; S.init(M, D, G, (int)blockIdx.x);
      pg8::EpiResid<false> E{3072, out, out, mod + 2 * 3072 + 2048, nullptr, nullptr, nullptr, nullptr};
      pg8::gemm_phase<pg8::EpiResid<false>, pg8::StaticOrder, true, true>(lds, g, S, E); }
}

extern "C" void kernel_launch(void* const* d_in, const int* in_sizes, int n_in, void* d_out, int out_size, void* d_ws, size_t ws_size, hipStream_t stream) {
    static int grid = 0;
    if (grid == 0) {
        if (n_in != 16 || out_size != M * D || ws_size < WS_END) { fprintf(stderr, "kernel_launch: unexpected sizes n_in %d out %d ws %zu\n", n_in, out_size, ws_size); grid = -1; return; }
        int dev = 0, cus = 0, per_cu = 0;
        (void)hipGetDevice(&dev); (void)hipDeviceGetAttribute(&cus, hipDeviceAttributeMultiprocessorCount, dev);
        if (hipFuncSetAttribute((const void*)fwd_megakernel, hipFuncAttributeMaxDynamicSharedMemorySize, LDS_BYTES) != hipSuccess) { fprintf(stderr, "kernel_launch: hipFuncSetAttribute failed\n"); grid = -1; return; }
        if (hipOccupancyMaxActiveBlocksPerMultiprocessor(&per_cu, (const void*)fwd_megakernel, NTHR, LDS_BYTES) != hipSuccess || per_cu < 1) { fprintf(stderr, "kernel_launch: occupancy query gave %d\n", per_cu); per_cu = 1; }
        (void)hipGetLastError();
        grid = cus * per_cu;
    }
    if (grid < 0) return;
    (void)hipMemsetAsync((char*)d_ws + WS_CTL, 0, CTL_ZERO_BYTES, stream);
    Args a{};
    for (int i = 0; i < 16; ++i) a.in[i] = (const float*)d_in[i];
    a.out = (float*)d_out; a.ws = (unsigned char*)d_ws;
    void* kargs[] = {&a};
    hipError_t e = hipLaunchCooperativeKernel((const void*)fwd_megakernel, dim3(grid), dim3(NTHR), kargs, LDS_BYTES, stream);
    if (e != hipSuccess) fprintf(stderr, "cooperative launch failed: %s (grid %d)\n", hipGetErrorString(e), grid);
}
```

```cpp
#include <hip/hip_runtime.h>
#include <cstdio>
#include <cstdint>
namespace pg8 {
#define PG8_LAS __attribute__((address_space(3)))
typedef unsigned short bf16_t;
typedef short bf16x8 __attribute__((ext_vector_type(8)));
typedef float f32x4 __attribute__((ext_vector_type(4)));
typedef unsigned u32x4 __attribute__((ext_vector_type(4)));
constexpr int BM = 256, BK = 64, HALF = 128, HTB = HALF * BK * 2  , STAGE_BYTES = 8 * HTB, NXCD = 8, WGM = 8;

__host__ __device__ __forceinline__ int lds_byte(int r, int c) { const int st = (r >> 4) * 2 + (c >> 5), rr = r & 15, cc = c & 31, ob = rr * 64 + cc * 2; return st * 1024 + (ob ^ (((ob >> 9) & 1) << 5)); }
__host__ __device__ __forceinline__ void stage_rc(int b, int& R, int& C) { const int st = b / 1024, sb = b % 1024, swz = sb ^ (((sb >> 9) & 1) << 5); R = (st >> 1) * 16 + swz / 64; C = (st & 1) * 32 + (swz % 64) / 2; }
__host__ __device__ __forceinline__ int perm32(int rho) { const int n = rho >> 4, i = rho & 15; return 8 * (i >> 2) + 4 * n + (i & 3); }

struct Unit { int pm, pn; };
struct Gemm { const bf16_t* A; const bf16_t* Bt; int M, N, K; };

struct StaticOrder {
    int nM, nN, nwg, G, c;
    __host__ __device__ void init(int M, int N, int G_, int c_) { nM = M / BM; nN = N / BM; nwg = nM * nN; G = G_; c = c_; }
    __host__ __device__ bool next(int i, Unit& u) const {
        const long L = (long)i * G + c; if (L >= nwg) return false;
        int wgid = (int)L; { const int q = nwg / NXCD, r = nwg % NXCD, xcd = wgid % NXCD, off = wgid / NXCD; wgid = (xcd < r ? xcd * (q + 1) : r * (q + 1) + (xcd - r) * q) + off; }
        const int nig = WGM * nN, gid = wgid / nig, fm = gid * WGM, gsz = (nM - fm) < WGM ? (nM - fm) : WGM;
        u.pm = fm + ((wgid % nig) % gsz); u.pn = (wgid % nig) / gsz; return true;
    }
    __device__ __forceinline__ void a_ready(const Unit&) const {}
    __device__ __forceinline__ void done(const Unit&) const {}
};

__device__ __forceinline__ unsigned cvt_pk_bf16(float lo, float hi) { unsigned r; asm volatile("v_cvt_pk_bf16_f32 %0, %1, %2" : "=v"(r) : "v"(lo), "v"(hi)); return r; }
__device__ __forceinline__ void st16_wt(void* p, u32x4 v) { asm volatile("global_store_dwordx4 %0, %1, off sc1\n\ts_nop 1" :: "v"(p), "v"(v) : "memory"); }
typedef float f32x2 __attribute__((ext_vector_type(2)));
__device__ __forceinline__ f32x2 gelu_pk(f32x2 v) {
    const f32x2 av = __builtin_elementwise_abs(v), d = av * 0.2316418882f + 1.0f;
    f32x2 t; t.x = __builtin_amdgcn_rcpf(d.x); t.y = __builtin_amdgcn_rcpf(d.y);
    f32x2 q = t * 0.5307027145f + (-0.7265760135f); q = q * t + 0.7107068705f; q = q * t + (-0.142248368f); q = q * t + 0.127414796f; q = q * t;
    const f32x2 s = (v * v) * (-0.72134752044f);
    f32x2 e; e.x = __builtin_amdgcn_exp2f(s.x); e.y = __builtin_amdgcn_exp2f(s.y);
    const f32x2 m = v * (q * e), r = v - m;
    f32x2 o; o.x = v.x < 0.f ? m.x : r.x; o.y = v.y < 0.f ? m.y : r.y; return o;
}

template <int ACT  > struct EpiBf16 {
    static constexpr bool PERM = true, AFTER_DRAIN = false; static_assert(ACT == 0 || ACT == 1, "EpiBf16: ACT is 0 (none) or 1 (gelu_pk)");
    bf16_t* O; int ldc; const float* bias; int split_cols; size_t split_stride; float scale0;
    __device__ __forceinline__ void operator()(const f32x4 (&acc)[2][2][4][2], const Unit& u, int wr, int wc, int fr, int fq) const {
        const int row0 = u.pm * BM + wr * 64 + fr; int colt = u.pn * BM; bf16_t* base = O;
        float sc = 1.f; if (split_cols) { const int t = colt / split_cols; base += (size_t)t * split_stride; colt -= t * split_cols; if (t == 0) sc = scale0; }
        const int col0 = colt + wc * 32 + 8 * fq, bcol0 = u.pn * BM + wc * 32 + 8 * fq;
        f32x4 bv[2][2];
#pragma unroll
        for (int bj = 0; bj < 2; ++bj)
#pragma unroll
            for (int n = 0; n < 2; ++n) bv[bj][n] = bias ? *(const f32x4*)(bias + bcol0 + bj * HALF + 4 * n) : (f32x4){0.f, 0.f, 0.f, 0.f};
#pragma unroll
        for (int ai = 0; ai < 2; ++ai)
#pragma unroll
            for (int m = 0; m < 4; ++m) { bf16_t* rowp = base + (size_t)(row0 + ai * HALF + m * 16) * ldc + col0;
#pragma unroll
                for (int bj = 0; bj < 2; ++bj) { f32x4 v0 = acc[ai][bj][m][0] + bv[bj][0], v1 = acc[ai][bj][m][1] + bv[bj][1];
                    if (ACT == 1) { f32x2 a = gelu_pk((f32x2){v0[0], v0[1]}), b = gelu_pk((f32x2){v0[2], v0[3]}), c = gelu_pk((f32x2){v1[0], v1[1]}), d = gelu_pk((f32x2){v1[2], v1[3]});
                        v0 = (f32x4){a.x, a.y, b.x, b.y}; v1 = (f32x4){c.x, c.y, d.x, d.y}; }
                    v0 = v0 * sc; v1 = v1 * sc; u32x4 w; w.x = cvt_pk_bf16(v0[0], v0[1]); w.y = cvt_pk_bf16(v0[2], v0[3]); w.z = cvt_pk_bf16(v1[0], v1[1]); w.w = cvt_pk_bf16(v1[2], v1[3]);
                    st16_wt(rowp + bj * HALF, w); } }
    }
};
struct EpiOdd {
    static constexpr bool PERM = true, AFTER_DRAIN = false;
    float c2; void* pA; const float* pB; const float* pC; const float* pD; const float* pE;
    __device__ __forceinline__ void operator()(const f32x4 (&acc)[2][2][4][2], const Unit& u, int wr, int wc, int fr, int fq) const {
        const int row0 = u.pm * BM + wr * 64 + fr;
        {
            bf16_t* QKVG = (bf16_t*)pA; const float* gq = pB; const float* gk = pC; const float* biasp = pD; const float* rowss = pE;
            const int type = u.pn >> 2, head = 4 * (u.pn & 3) + wc;
            bf16_t* base = QKVG + (size_t)type * ((size_t)16384 * 1024) + head * 64 + 8 * fq;
            const float* bp = biasp + (u.pm >= 32 ? 4352 : 0) + u.pn * BM + wc * 32 + 8 * fq;
            f32x4 gg[2][2], bb[2][2];
#pragma unroll
            for (int bj = 0; bj < 2; ++bj)
#pragma unroll
                for (int n = 0; n < 2; ++n) { f32x4 g1 = (f32x4){1.f, 1.f, 1.f, 1.f};
                    if (type == 0) g1 = *(const f32x4*)(gq + 32 * bj + 8 * fq + 4 * n) * c2; else if (type == 1) g1 = *(const f32x4*)(gk + 32 * bj + 8 * fq + 4 * n);
                    gg[bj][n] = g1; bb[bj][n] = *(const f32x4*)(bp + bj * HALF + 4 * n); }
            float rr8[2][4];
#pragma unroll
            for (int ai = 0; ai < 2; ++ai)
#pragma unroll
                for (int m = 0; m < 4; ++m) rr8[ai][m] = rowss[row0 + ai * HALF + m * 16];
#pragma unroll
            for (int ai = 0; ai < 2; ++ai)
#pragma unroll
                for (int m = 0; m < 4; ++m) {
                    const int row = row0 + ai * HALF + m * 16;
                    const float rrow = __builtin_amdgcn_rsqf(rr8[ai][m] * (1.0f / 1024.0f) + 1e-6f);
                    f32x4 v[2][2];
#pragma unroll
                    for (int bj = 0; bj < 2; ++bj)
#pragma unroll
                        for (int n = 0; n < 2; ++n) v[bj][n] = acc[ai][bj][m][n] * rrow + bb[bj][n];
                    float rs = 1.f;
                    if (type < 2) { float ss = 0.f;
#pragma unroll
                        for (int bj = 0; bj < 2; ++bj)
#pragma unroll
                            for (int n = 0; n < 2; ++n) { const f32x4 x = v[bj][n]; ss += (x[0] * x[0] + x[1] * x[1]) + (x[2] * x[2] + x[3] * x[3]); }
                        ss += __shfl_xor(ss, 16); ss += __shfl_xor(ss, 32);
                        rs = __builtin_amdgcn_rsqf(ss * (1.0f / 64.0f) + 1e-6f); }
                    bf16_t* rowp = base + (size_t)row * 1024;
#pragma unroll
                    for (int bj = 0; bj < 2; ++bj) { const f32x4 v0 = v[bj][0] * rs * gg[bj][0], v1 = v[bj][1] * rs * gg[bj][1];
                        u32x4 w; w.x = cvt_pk_bf16(v0[0], v0[1]); w.y = cvt_pk_bf16(v0[2], v0[3]); w.z = cvt_pk_bf16(v1[0], v1[1]); w.w = cvt_pk_bf16(v1[2], v1[3]);
                        st16_wt(rowp + 32 * bj, w); } }
        }
    }
};
template <bool FUSE> struct EpiResid {
    static constexpr bool PERM = true, AFTER_DRAIN = false; static constexpr int kind = FUSE ? 2 : 1, MB = FUSE ? 2 : 4;
    int ival; void* pA; const float* pB; const float* pC; const float* pD; const float* pE; bf16_t* pF; float* pG;
    __device__ __forceinline__ void operator()(const f32x4 (&acc)[2][2][4][2], const Unit& u, int wr, int wc, int fr, int fq) const {
        const int row0 = u.pm * BM + wr * 64 + fr;
        {
            float* out = (float*)pA; const float* base = pB; const float* gate = pC; const float* ng = pD; const float* scl = pE; bf16_t* A1 = pF; float* rowss = pG;
            const int col0 = u.pn * BM + wc * 32 + 8 * fq; const int bo = (u.pm >= 32) ? ival : 0;
            f32x4 gv[2][2], gm[2][2];
#pragma unroll
            for (int bj = 0; bj < 2; ++bj)
#pragma unroll
                for (int n = 0; n < 2; ++n) { gv[bj][n] = *(const f32x4*)(gate + bo + col0 + bj * HALF + 4 * n);
                    if (kind == 2) gm[bj][n] = *(const f32x4*)(ng + col0 + bj * HALF + 4 * n) * (*(const f32x4*)(scl + bo + col0 + bj * HALF + 4 * n) + 1.0f); }
#pragma unroll
            for (int ai = 0; ai < 2; ++ai)
#pragma unroll
                for (int mp = 0; mp < 4 / MB; ++mp) {
                    f32x4 bs[MB][2][2];
#pragma unroll
                    for (int mi = 0; mi < MB; ++mi) { const size_t off = (size_t)(row0 + ai * HALF + (MB * mp + mi) * 16) * 1024 + col0;
#pragma unroll
                        for (int bj = 0; bj < 2; ++bj)
#pragma unroll
                            for (int n = 0; n < 2; ++n) bs[mi][bj][n] = *(const f32x4*)(base + off + bj * HALF + 4 * n); }
#pragma unroll
                    for (int mi = 0; mi < MB; ++mi) { const int m = MB * mp + mi; const int row = row0 + ai * HALF + m * 16; const size_t off = (size_t)row * 1024 + col0;
                        float ss = 0.f;
#pragma unroll
                        for (int bj = 0; bj < 2; ++bj) { f32x4 x1[2];
#pragma unroll
                            for (int n = 0; n < 2; ++n) { x1[n] = bs[mi][bj][n] + gv[bj][n] * acc[ai][bj][m][n];
                                *(f32x4*)(out + off + bj * HALF + 4 * n) = x1[n]; }
                            if (kind == 2) { ss += (x1[0][0] * x1[0][0] + x1[0][1] * x1[0][1]) + (x1[0][2] * x1[0][2] + x1[0][3] * x1[0][3]) + (x1[1][0] * x1[1][0] + x1[1][1] * x1[1][1]) + (x1[1][2] * x1[1][2] + x1[1][3] * x1[1][3]);
                                const f32x4 a0 = x1[0] * gm[bj][0], a1 = x1[1] * gm[bj][1];
                                u32x4 w; w.x = cvt_pk_bf16(a0[0], a0[1]); w.y = cvt_pk_bf16(a0[2], a0[3]); w.z = cvt_pk_bf16(a1[0], a1[1]); w.w = cvt_pk_bf16(a1[2], a1[3]);
                                *(u32x4*)(A1 + off + bj * HALF) = w; } }
                        if (kind == 2) { ss += __shfl_xor(ss, 16); ss += __shfl_xor(ss, 32); if (fq == 0) atomicAdd(rowss + row, ss); } }
                    asm volatile("" ::: "memory");
                }
        }
    }
};
template <class Epi, class Sched, bool ALIGN_EPI = false, bool SP2 = false>
__device__ __forceinline__ void gemm_phase(PG8_LAS unsigned char* lds, const Gemm g, const Sched& S, const Epi& E) {
    int tid = threadIdx.x; asm volatile("" : "+v"(tid)); const int wid = __builtin_amdgcn_readfirstlane(tid >> 6), lane = tid & 63, wr = wid >> 2, wc = wid & 3, fr = lane & 15, fq = lane >> 4;
    const int K = g.K, nt = K / BK;
    unsigned voffA[2], voffB[2];
#pragma unroll
    for (int i = 0; i < 2; ++i) { int R, C; stage_rc(tid * 16 + i * 8192, R, C); const int Rb = Epi::PERM ? ((R & ~31) + perm32(R & 31)) : R;
        voffA[i] = (unsigned)(R * K + C) * 2u; voffB[i] = (unsigned)(Rb * K + C) * 2u; }
    const size_t kstep = (size_t)(BK * 2);
    const size_t hstep = (size_t)HALF * K * 2;
    const size_t tstep = 2 * hstep;
    const unsigned ldsw = (unsigned)wid * 1024u;
    const int aoff = lds_byte(wr * 64 + fr, fq * 8), boff = lds_byte(wc * 32 + fr, fq * 8);
#define PG8_SA(b, h) (((b) * 2 + (h)) * HTB)
#define PG8_SB(b, h) ((4 + (b) * 2 + (h)) * HTB)
#define PG8_STAGE(bufoff, gbase, voff) do { _Pragma("unroll") for (int _i = 0; _i < 2; ++_i) \
        __builtin_amdgcn_global_load_lds((const unsigned*)((const char*)(gbase) + (voff)[_i]), (PG8_LAS unsigned*)(lds + (bufoff) + ldsw + _i * 8192), 16, 0, 0); } while (0)
#define PG8_LDA(dst, b, h) do { _Pragma("unroll") for (int m = 0; m < 4; ++m) _Pragma("unroll") for (int k = 0; k < 2; ++k) dst[m][k] = *(const PG8_LAS bf16x8*)(lds + PG8_SA(b, h) + aoff + m * 2048 + k * 1024); } while (0)
#define PG8_LDB(dst, b, h) do { _Pragma("unroll") for (int n = 0; n < 2; ++n) _Pragma("unroll") for (int k = 0; k < 2; ++k) dst[n][k] = *(const PG8_LAS bf16x8*)(lds + PG8_SB(b, h) + boff + n * 2048 + k * 1024); } while (0)
#define PG8_MMA(ai, bj, At, Bt) do { __builtin_amdgcn_s_setprio(1); _Pragma("unroll") for (int m = 0; m < 4; ++m) _Pragma("unroll") for (int n = 0; n < 2; ++n) _Pragma("unroll") for (int k = 0; k < 2; ++k) \
        acc[ai][bj][m][n] = __builtin_amdgcn_mfma_f32_16x16x32_bf16(Bt[n][k], At[m][k], acc[ai][bj][m][n], 0, 0, 0); __builtin_amdgcn_s_setprio(0); } while (0)
#define PG8_WAIT_V(n) asm volatile("s_waitcnt vmcnt(" #n ")" ::: "memory")
#define PG8_WAIT_L(n) asm volatile("s_waitcnt lgkmcnt(" #n ")" ::: "memory")
#define PG8_BAR __builtin_amdgcn_s_barrier()
#define PG8_SCHED __builtin_amdgcn_sched_barrier(0)
    Unit cur, nxt; int ui = 0;
    if (!S.next(0, cur)) return;
    f32x4 acc[2][2][4][2];
#pragma unroll
    for (int a = 0; a < 2; ++a)
#pragma unroll
        for (int b = 0; b < 2; ++b)
#pragma unroll
            for (int m = 0; m < 4; ++m)
#pragma unroll
                for (int n = 0; n < 2; ++n) acc[a][b][m][n] = (f32x4){0.f, 0.f, 0.f, 0.f};
    bf16x8 At[4][2], B0[2][2], B1[2][2];
    const char* cA = (const char*)g.A + (size_t)cur.pm * tstep; const char* cB = (const char*)g.Bt + (size_t)cur.pn * tstep;
    S.a_ready(cur);
    if constexpr (SP2) {
        PG8_STAGE(PG8_SB(0, 0), cB, voffB); PG8_STAGE(PG8_SB(0, 1), cB + hstep, voffB); PG8_STAGE(PG8_SA(0, 0), cA, voffA); PG8_STAGE(PG8_SA(0, 1), cA + hstep, voffA);
        if (wr == 1) PG8_BAR;
        PG8_WAIT_V(2); PG8_BAR;
        PG8_STAGE(PG8_SB(1, 0), cB + kstep, voffB); PG8_STAGE(PG8_SA(1, 0), cA + kstep, voffA); PG8_STAGE(PG8_SB(1, 1), cB + hstep + kstep, voffB);
        PG8_WAIT_V(6); PG8_BAR;
    } else {
        PG8_STAGE(PG8_SB(0, 0), cB, voffB); PG8_STAGE(PG8_SA(0, 0), cA, voffA); PG8_STAGE(PG8_SB(0, 1), cB + hstep, voffB); PG8_STAGE(PG8_SA(0, 1), cA + hstep, voffA);
        if (wr == 1) PG8_BAR;
        PG8_WAIT_V(4); PG8_BAR;
        PG8_STAGE(PG8_SB(1, 0), cB + kstep, voffB); PG8_STAGE(PG8_SA(1, 0), cA + kstep, voffA); PG8_STAGE(PG8_SB(1, 1), cB + hstep + kstep, voffB);
        PG8_WAIT_V(6); PG8_BAR;
    }
    for (;;) {
        const bool has_next = S.next(ui + 1, nxt);
        const char* nA = has_next ? (const char*)g.A + (size_t)nxt.pm * tstep : cA; const char* nB = has_next ? (const char*)g.Bt + (size_t)nxt.pn * tstep : cB;
        for (int t = 0; t < nt; t += 2) {
            const bool last = (t == nt - 2);
            const char* a1 = cA + (size_t)(t + 1) * kstep;
            const char* a2 = last ? nA : cA + (size_t)(t + 2) * kstep; const char* b2 = last ? nB : cB + (size_t)(t + 2) * kstep;
            const char* a3 = a2 + kstep; const char* b3 = b2 + kstep;
            if (last && has_next) S.a_ready(nxt);
            if constexpr (SP2) {
            PG8_LDB(B0, 0, 0); PG8_LDB(B1, 0, 1); PG8_SCHED; PG8_LDA(At, 0, 0); PG8_STAGE(PG8_SA(1, 1), a1 + hstep, voffA);
            PG8_WAIT_V(8); PG8_WAIT_L(0); PG8_BAR; PG8_MMA(0, 0, At, B0); PG8_MMA(0, 1, At, B1); PG8_BAR; PG8_SCHED;
            PG8_LDA(At, 0, 1); PG8_STAGE(PG8_SB(0, 0), b2, voffB); PG8_STAGE(PG8_SB(0, 1), b2 + hstep, voffB); PG8_STAGE(PG8_SA(0, 0), a2, voffA);
            PG8_WAIT_V(8); PG8_WAIT_L(0); PG8_BAR; PG8_MMA(1, 0, At, B0); PG8_MMA(1, 1, At, B1); PG8_BAR; PG8_SCHED;
            PG8_LDB(B0, 1, 0); PG8_LDB(B1, 1, 1); PG8_SCHED; PG8_LDA(At, 1, 0); PG8_STAGE(PG8_SA(0, 1), a2 + hstep, voffA);
            PG8_WAIT_V(8); PG8_WAIT_L(0); PG8_BAR; PG8_MMA(0, 0, At, B0); PG8_MMA(0, 1, At, B1); PG8_BAR; PG8_SCHED;
            PG8_LDA(At, 1, 1); PG8_STAGE(PG8_SB(1, 0), b3, voffB); PG8_STAGE(PG8_SB(1, 1), b3 + hstep, voffB); PG8_STAGE(PG8_SA(1, 0), a3, voffA);
            PG8_WAIT_V(8); PG8_WAIT_L(0); PG8_BAR; PG8_MMA(1, 0, At, B0); PG8_MMA(1, 1, At, B1); PG8_BAR; PG8_SCHED;
            } else {
            PG8_LDB(B0, 0, 0); PG8_SCHED; PG8_LDA(At, 0, 0); PG8_STAGE(PG8_SA(1, 1), a1 + hstep, voffA);
            PG8_WAIT_L(8); PG8_BAR; PG8_WAIT_L(0); PG8_MMA(0, 0, At, B0); PG8_BAR; PG8_SCHED;
            PG8_LDB(B1, 0, 1); PG8_STAGE(PG8_SB(0, 0), b2, voffB);
            PG8_BAR; PG8_WAIT_L(0); PG8_MMA(0, 1, At, B1); PG8_BAR;
            PG8_LDA(At, 0, 1); PG8_STAGE(PG8_SA(0, 0), a2, voffA);
            PG8_BAR; PG8_WAIT_L(0); PG8_MMA(1, 0, At, B0); PG8_BAR; PG8_SCHED;
            PG8_STAGE(PG8_SB(0, 1), b2 + hstep, voffB);
            PG8_WAIT_V(6); PG8_BAR; PG8_MMA(1, 1, At, B1); PG8_BAR;
            PG8_LDB(B0, 1, 0); PG8_SCHED; PG8_LDA(At, 1, 0); PG8_STAGE(PG8_SA(0, 1), a2 + hstep, voffA);
            PG8_WAIT_L(8); PG8_BAR; PG8_WAIT_L(0); PG8_MMA(0, 0, At, B0); PG8_BAR; PG8_SCHED;
            PG8_LDB(B1, 1, 1); PG8_STAGE(PG8_SB(1, 0), b3, voffB);
            PG8_BAR; PG8_WAIT_L(0); PG8_MMA(0, 1, At, B1); PG8_BAR;
            PG8_LDA(At, 1, 1); PG8_STAGE(PG8_SA(1, 0), a3, voffA);
            PG8_BAR; PG8_WAIT_L(0); PG8_MMA(1, 0, At, B0); PG8_BAR; PG8_SCHED;
            PG8_STAGE(PG8_SB(1, 1), b3 + hstep, voffB);
            PG8_WAIT_V(6); PG8_BAR; PG8_MMA(1, 1, At, B1); PG8_BAR;
            }
        }
        if constexpr (ALIGN_EPI) { if (wr == 0) PG8_BAR; }
        if constexpr (!Epi::AFTER_DRAIN) { E(acc, cur, wr, wc, fr, fq); S.done(cur); }
        if (!has_next) break;
#pragma unroll
        for (int a = 0; a < 2; ++a)
#pragma unroll
            for (int b = 0; b < 2; ++b)
#pragma unroll
                for (int m = 0; m < 4; ++m)
#pragma unroll
                    for (int n = 0; n < 2; ++n) acc[a][b][m][n] = (f32x4){0.f, 0.f, 0.f, 0.f};
        cur = nxt; cA = nA; cB = nB; ++ui;
        if constexpr (ALIGN_EPI) { if (wr == 1) PG8_BAR; }
    }
    PG8_WAIT_V(0);
    if constexpr (!ALIGN_EPI) { if (wr == 0) PG8_BAR; }
    PG8_BAR;
    if constexpr (Epi::AFTER_DRAIN) { E.fused(acc, cur, wr, wc, fr, fq, lds, wid, lane); S.done(cur); }
#undef PG8_SA
#undef PG8_SB
#undef PG8_STAGE
#undef PG8_LDA
#undef PG8_LDB
#undef PG8_MMA
#undef PG8_WAIT_V
#undef PG8_WAIT_L
#undef PG8_BAR
#undef PG8_SCHED
}
}

#include <hip/hip_bf16.h>
#include <cmath>
namespace attn_body {
using bf16=__hip_bfloat16;
using bf16x8=__attribute__((ext_vector_type(8)))short;
using s16x4=__attribute__((ext_vector_type(4)))short;
using f32x16=__attribute__((ext_vector_type(16)))float;
using u32x4=__attribute__((ext_vector_type(4)))unsigned;
constexpr int BATCH=2,NHEAD=16,SEQ=8192,D=64,DM=NHEAD*D;
constexpr int NW=8,QBLK=32,QB=QBLK*NW,KVBLK=64,NQB=SEQ/QB;
constexpr int ATTN_PITCH=DM, ATTN_UNIT_ROWS=QB;
__device__ __forceinline__ int crow(int r,int hi){return (r&3)+8*(r>>2)+4*hi;}
#define SBAR() __builtin_amdgcn_sched_barrier(0)
__device__ __forceinline__ void cmask(f32x16&p0,f32x16&p1,int jb,int qrel,int hi){
  const float NEG=-INFINITY; int kb=64*jb+4*hi;
  #pragma unroll
  for(int r=0;r<16;++r){int kv=kb+(r&3)+8*(r>>2); if(kv>qrel)p0[r]=NEG; if(kv+32>qrel)p1[r]=NEG;}
}

constexpr int NSLOT=3, SLOTB=8192;
constexpr int LDS_K=0, LDS_V=NSLOT*SLOTB, LDS_WS=2*NSLOT*SLOTB, LDS_OST=LDS_WS+NW*64*4, LDS_BYTES=LDS_OST+NW*4096, LDS_CK=LDS_BYTES, LDS_MISC=LDS_CK+32768, LDS_TOTAL=LDS_MISC+64+256;
constexpr float C2=0.125f*1.4426950408889634f;
__device__ __forceinline__ void glds16(const void*gsrc,unsigned lds_dst){unsigned keep;
  asm volatile("s_mov_b32 %0, m0\n\ts_mov_b32 m0, %2\n\ts_nop 0\n\tglobal_load_lds_dwordx4 %1, off\n\ts_mov_b32 m0, %0":"=&s"(keep):"v"(gsrc),"s"(lds_dst):"memory");}
__device__ __forceinline__ float max3f(float a,float b,float c){float r;asm("v_max3_f32 %0, %1, %2, %3":"=v"(r):"v"(a),"v"(b),"v"(c));return r;}
__device__ __forceinline__ float max2f(float a,float b){float r;asm("v_max_f32_e32 %0, %1, %2":"=v"(r):"v"(a),"v"(b));return r;}
__device__ __forceinline__ float fadd_s(float a,float b){float r;asm("v_add_f32_e32 %0, %1, %2":"=v"(r):"v"(a),"v"(b));return r;}
__device__ __forceinline__ float fsub_s(float a,float b){float r;asm("v_sub_f32_e32 %0, %1, %2":"=v"(r):"v"(a),"v"(b));return r;}
typedef float f32x2_t __attribute__((ext_vector_type(2))); typedef __bf16 bf16x2_t __attribute__((ext_vector_type(2)));
__device__ __forceinline__ unsigned cvtpk_s(float lo,float hi){f32x2_t v={lo,hi};bf16x2_t b=__builtin_convertvector(v,bf16x2_t);return __builtin_bit_cast(unsigned,b);}
#define WAIT_BAR(N) asm volatile("s_waitcnt vmcnt(" #N ") lgkmcnt(0)\n\ts_barrier":::"memory")

__device__ __forceinline__ void qkt(f32x16&p0,f32x16&p1,const char*Kslot,const bf16x8*qr,const f32x16&negm,int r32,int hi){
  const char*kb=Kslot+hi*1024+r32*16;
  #pragma unroll
  for(int d0=0;d0<4;++d0){
    const bf16x8 b0=*reinterpret_cast<const bf16x8*>(kb+d0*2048);
    const bf16x8 b1=*reinterpret_cast<const bf16x8*>(kb+d0*2048+512);
    if(d0==0){p0=__builtin_amdgcn_mfma_f32_32x32x16_bf16(b0,qr[0],negm,0,0,0);p1=__builtin_amdgcn_mfma_f32_32x32x16_bf16(b1,qr[0],negm,0,0,0);}
    else{p0=__builtin_amdgcn_mfma_f32_32x32x16_bf16(b0,qr[d0],p0,0,0,0);p1=__builtin_amdgcn_mfma_f32_32x32x16_bf16(b1,qr[d0],p1,0,0,0);}}
}
typedef __attribute__((address_space(3))) const char* lds_cptr;
typedef short v4i16_t __attribute__((ext_vector_type(4)));
__device__ __forceinline__ void kload8(bf16x8*kf,lds_cptr kp){
  kf[0]=*(const __attribute__((address_space(3))) bf16x8*)(kp);      kf[1]=*(const __attribute__((address_space(3))) bf16x8*)(kp+512);
  kf[2]=*(const __attribute__((address_space(3))) bf16x8*)(kp+2048); kf[3]=*(const __attribute__((address_space(3))) bf16x8*)(kp+2560);
  kf[4]=*(const __attribute__((address_space(3))) bf16x8*)(kp+4096); kf[5]=*(const __attribute__((address_space(3))) bf16x8*)(kp+4608);
  kf[6]=*(const __attribute__((address_space(3))) bf16x8*)(kp+6144); kf[7]=*(const __attribute__((address_space(3))) bf16x8*)(kp+6656);
}
__device__ __forceinline__ void kload2(bf16x8*kf,lds_cptr kp,int j){ kf[2*j]=*(const __attribute__((address_space(3))) bf16x8*)(kp+j*2048); kf[2*j+1]=*(const __attribute__((address_space(3))) bf16x8*)(kp+j*2048+512); }
__device__ __forceinline__ s16x4 vtr(lds_cptr p){ return __builtin_bit_cast(s16x4,__builtin_amdgcn_ds_read_tr16_b64_v4i16((__attribute__((address_space(3))) v4i16_t*)p)); }
__device__ __forceinline__ float rowmax(const f32x16&p0,const f32x16&p1){
  float a=max3f(p0[0],p0[1],p1[0]),b=max3f(p0[2],p0[3],p1[1]);a=max3f(a,p1[2],p1[3]);
  #pragma unroll
  for(int r=4;r<16;r+=4){a=max3f(a,p0[r],p0[r+1]);b=max3f(b,p0[r+2],p0[r+3]);a=max3f(a,p1[r],p1[r+1]);b=max3f(b,p1[r+2],p1[r+3]);}
  const float m=max2f(a,b);
  auto rr=__builtin_amdgcn_permlane32_swap(__float_as_uint(m),__float_as_uint(m),false,false);
  return max2f(__uint_as_float(rr[0]),__uint_as_float(rr[1]));
}
__device__ __forceinline__ void pv(f32x16*o,int vb,bf16x8 pa0,bf16x8 pa1,bf16x8 pa2,bf16x8 pa3){
  #pragma unroll
  for(int d0=0;d0<2;++d0){s16x4 lo[4],hi[4];
    #pragma unroll
    for(int ks=0;ks<4;++ks){
      asm volatile("ds_read_b64_tr_b16 %0,%1 offset:%c2":"=&v"(lo[ks]):"v"(vb),"i"(d0*4096+ks*1024):"memory");
      asm volatile("ds_read_b64_tr_b16 %0,%1 offset:%c2":"=&v"(hi[ks]):"v"(vb),"i"(d0*4096+ks*1024+512):"memory");}
    asm volatile("s_waitcnt lgkmcnt(0)":::"memory");SBAR();
    #define PK(k) (bf16x8){lo[k][0],lo[k][1],lo[k][2],lo[k][3],hi[k][0],hi[k][1],hi[k][2],hi[k][3]}
    o[d0]=__builtin_amdgcn_mfma_f32_32x32x16_bf16(pa0,PK(0),o[d0],0,0,0);
    o[d0]=__builtin_amdgcn_mfma_f32_32x32x16_bf16(pa1,PK(1),o[d0],0,0,0);
    o[d0]=__builtin_amdgcn_mfma_f32_32x32x16_bf16(pa2,PK(2),o[d0],0,0,0);
    o[d0]=__builtin_amdgcn_mfma_f32_32x32x16_bf16(pa3,PK(3),o[d0],0,0,0);
    #undef PK
  }
}

#ifndef ATTN_STORE16
#define ATTN_STORE16(p,v) (*(u32x4*)(p)=(v))
#endif
template<int THRL> __device__ __forceinline__ void attn_unit(int b,int h,int qb,int t0,float cqv,float mfix,const float*__restrict__ cf,float cref,unsigned*counter,const bf16*Q,const bf16*__restrict__ K,const bf16*__restrict__ V,bf16*O,const bf16*__restrict__ G,char*shm){
  int tid=threadIdx.x; asm volatile("":"+v"(tid)); const int lane=tid&63,r32=lane&31,hi=lane>>5; const int wid=__builtin_amdgcn_readfirstlane(tid>>6);
  const long rowbase=(long)b*SEQ; const int q0=qb*QB;
  const bf16*Qw=Q+(rowbase+q0+wid*QBLK)*DM+h*D;
  const bf16*Kh=K+(rowbase+(long)t0*KVBLK)*DM+h*D,*Vh=V+(rowbase+(long)t0*KVBLK)*DM+h*D;
  const unsigned lds0=(unsigned)(uintptr_t)shm;
  float*wsf=(float*)(shm+LDS_WS)+wid*64;
  const bf16*ksrc=Kh+(long)lane*DM+wid*8;
  const bf16*vsrc=Vh+(long)(16*(wid&3)+(lane>>2))*DM+(wid>>2)*32+(lane&3)*8;
  const unsigned kdst=lds0+LDS_K+wid*1024, vdst=lds0+LDS_V+wid*1024;
  #define DMA_K(t,slot) glds16(ksrc+(long)(t)*KVBLK*DM,(unsigned)__builtin_amdgcn_readfirstlane(kdst+(slot)))
  #define DMA_V(t,slot) glds16(vsrc+(long)(t)*KVBLK*DM,(unsigned)__builtin_amdgcn_readfirstlane(vdst+(slot)))
  const int vb0=(int)(lds0+LDS_V)+((lane>>4)&1)*32+(lane&3)*8+(4*hi+((lane&15)>>2))*64;
  const char*Kbase=shm+LDS_K; bf16x8 kf[8];
  const lds_cptr shm3=(lds_cptr)shm; const lds_cptr kp0=shm3+LDS_K+hi*1024+r32*16; const lds_cptr vp0=shm3+LDS_V+((lane>>4)&1)*32+(lane&3)*8+(4*hi+((lane&15)>>2))*64;
  const int NT=(q0+QB)/KVBLK-t0;
  DMA_K(0,0);DMA_V(0,0);DMA_K(1,SLOTB);
  { __attribute__((address_space(3))) float* CK=(__attribute__((address_space(3))) float*)((__attribute__((address_space(3))) char*)shm+LDS_CK);
    for(int base=t0*64+tid;base<q0+QB;base+=4*NW*64){ float cv[4];
      #pragma unroll
      for(int j=0;j<4;++j){ const int idx=base+NW*64*j; cv[j]=(idx<q0+QB)?cf[idx]:0.f; }
      #pragma unroll
      for(int j=0;j<4;++j){ const int idx=base+NW*64*j; if(idx<q0+QB) CK[idx]=(cv[j]-cref)*1.4426950408889634f; } } }
  bf16x8 qr[4];
  #pragma unroll
  for(int d0=0;d0<4;++d0)qr[d0]=*reinterpret_cast<const bf16x8*>(&Qw[(long)r32*DM+d0*16+hi*8]);
  float mhat=mfix,l_reg=0.f;f32x16 o[2];o[0]=f32x16{};o[1]=f32x16{};const f32x16 negm=f32x16{};
  const int qrel=wid*QBLK+r32;
  #define CMASK(P0,P1,t) do{int jb_=(t)-(NT-4); if(jb_>=0)cmask(P0,P1,jb_,qrel,hi);}while(0)
  typedef float f32x4_t __attribute__((ext_vector_type(4)));
  #define BIAS(P0,P1,t) do{ const __attribute__((address_space(3))) f32x4_t* ckp_=(const __attribute__((address_space(3))) f32x4_t*)(shm3+LDS_CK+((t)+t0)*256+hi*16); \
    const float cm_=cqv-mhat; _Pragma("unroll") for(int j_=0;j_<4;++j_){ const f32x4_t a_=ckp_[2*j_], b_=ckp_[2*j_+8]; \
      _Pragma("unroll") for(int i_=0;i_<4;++i_){ P0[4*j_+i_]+=cm_-a_[i_]; P1[4*j_+i_]+=cm_-b_[i_]; } } }while(0)
  bool resc=false;
  #define START(P0,P1) do{ resc=false; \
    _Pragma("unroll") for(int r=0;r<16;++r)P0[r]=__builtin_amdgcn_exp2f(P0[r]); }while(0)
  #define RESC() do{}while(0)
  f32x16 pA0,pA1,pB0,pB1;
  int sl_prev=0,sl_cur=0,sl_next=SLOTB;
  #define ROT() do{sl_prev=sl_cur;sl_cur=sl_next;sl_next=(sl_next==(NSLOT-1)*SLOTB)?0:sl_next+SLOTB;}while(0)
  DMA_K(2,2*SLOTB);
  WAIT_BAR(3);
  qkt(pA0,pA1,Kbase,qr,negm,r32,hi);asm volatile("s_nop 15\n\ts_nop 7":"+v"(pA0),"+v"(pA1));BIAS(pA0,pA1,0);CMASK(pA0,pA1,0);
  START(pA0,pA1);
  _Pragma("unroll") for(int r=0;r<16;++r)pA1[r]=__builtin_amdgcn_exp2f(pA1[r]);
  WAIT_BAR(0);
  DMA_K(3,0);DMA_V(1,SLOTB);
  ROT();
  kload8(kf,kp0+sl_cur);
  WAIT_BAR(2);
  s16x4 vlo[8],vhi[8]; u32x4 pw0,pw1,pw2,pw3;
  #define PKW(P,B) cvtpk_s(P[B],P[B+1])
  #define PAF(k) __builtin_bit_cast(bf16x8,pw##k)
  #define VFR(i) (bf16x8){vlo[i][0],vlo[i][1],vlo[i][2],vlo[i][3],vhi[i][0],vhi[i][1],vhi[i][2],vhi[i][3]}
  #define PIN(x) asm volatile("":"+v"(x))
  #define MX3(a,b,c) __builtin_fmaxf(__builtin_fmaxf((a),(b)),(c))
  #define GAPA(MF,A0,A1,A2,A3,W0,W1,PW) do{ MF; sacc+=A0; sacc+=A1; sacc+=A2; sacc+=A3; PIN(sacc); W0; W1; PIN(PW); SBAR(); }while(0)
  #define EX(v) __builtin_amdgcn_exp2f(v)
  #define GAPB(MF,X,B) do{ MF; X[B]=EX(X[B]); X[B+1]=EX(X[B+1]); X[B+2]=EX(X[B+2]); X[B+3]=EX(X[B+3]); PIN(X); SBAR(); }while(0)
  #define VRD(i) do{ vlo[i]=vtr(vp_+(((i)>>2)*4096+((i)&3)*1024)); vhi[i]=vtr(vp_+(((i)>>2)*4096+((i)&3)*1024+512)); }while(0)
  #define KRD(G,j) do{ if(G){ kload2(kf,kp0+sl_next,j); SBAR(); } }while(0)
  #define STEP(C0,C1,P0,P1,t,GK,GV,GL) do{ SBAR(); \
    const lds_cptr vp_=vp0+sl_prev; \
    VRD(0); SBAR(); float sacc=(P0[0]+P0[1]); \
    GAPA(C0=__builtin_amdgcn_mfma_f32_32x32x16_bf16(kf[0],qr[0],negm,0,0,0), P0[2],P0[3],P0[4],P0[5],     pw0[0]=PKW(P0,0), pw0[1]=PKW(P0,2), pw0); \
    VRD(4); SBAR(); GAPA(C1=__builtin_amdgcn_mfma_f32_32x32x16_bf16(kf[1],qr[0],negm,0,0,0), P0[6],P0[7],P0[8],P0[9],     pw0[2]=PKW(P0,4), pw0[3]=PKW(P0,6), pw0); \
    VRD(1); SBAR(); GAPA(C0=__builtin_amdgcn_mfma_f32_32x32x16_bf16(kf[2],qr[1],C0,0,0,0),   P0[10],P0[11],P0[12],P0[13], pw1[0]=PKW(P0,8), pw1[1]=PKW(P0,10), pw1); \
    VRD(5); SBAR(); GAPA(C1=__builtin_amdgcn_mfma_f32_32x32x16_bf16(kf[3],qr[1],C1,0,0,0),   P0[14],P0[15],P1[0],P1[1],   pw1[2]=PKW(P0,12),pw1[3]=PKW(P0,14), pw1); \
    VRD(2); SBAR(); GAPA(C0=__builtin_amdgcn_mfma_f32_32x32x16_bf16(kf[4],qr[2],C0,0,0,0),   P1[2],P1[3],P1[4],P1[5],     pw2[0]=PKW(P1,0), pw2[1]=PKW(P1,2), pw2); \
    VRD(6); SBAR(); GAPA(C1=__builtin_amdgcn_mfma_f32_32x32x16_bf16(kf[5],qr[2],C1,0,0,0),   P1[6],P1[7],P1[8],P1[9],     pw2[2]=PKW(P1,4), pw2[3]=PKW(P1,6), pw2); \
    VRD(3); SBAR(); GAPA(C0=__builtin_amdgcn_mfma_f32_32x32x16_bf16(kf[6],qr[3],C0,0,0,0),   P1[10],P1[11],P1[12],P1[13], pw3[0]=PKW(P1,8), pw3[1]=PKW(P1,10), pw3); \
    VRD(7); SBAR(); GAPA(C1=__builtin_amdgcn_mfma_f32_32x32x16_bf16(kf[7],qr[3],C1,0,0,0),   P1[14],P1[15],0.f,0.f,       pw3[2]=PKW(P1,12),pw3[3]=PKW(P1,14), pw3); \
    l_reg+=sacc; \
    if(GK){DMA_K((t)+3,sl_cur);} if(GV){DMA_V((t)+1,sl_next);} \
    BIAS(C0,C1,t); CMASK(C0,C1,t); \
    SBAR(); \
    GAPB(o[0]=__builtin_amdgcn_mfma_f32_32x32x16_bf16(PAF(0),VFR(0),o[0],0,0,0), C0,0); \
    GAPB(o[1]=__builtin_amdgcn_mfma_f32_32x32x16_bf16(PAF(0),VFR(4),o[1],0,0,0), C0,4); \
    KRD(GL,0); GAPB(o[0]=__builtin_amdgcn_mfma_f32_32x32x16_bf16(PAF(1),VFR(1),o[0],0,0,0), C0,8); \
    KRD(GL,1); GAPB(o[1]=__builtin_amdgcn_mfma_f32_32x32x16_bf16(PAF(1),VFR(5),o[1],0,0,0), C0,12); \
    KRD(GL,2); GAPB(o[0]=__builtin_amdgcn_mfma_f32_32x32x16_bf16(PAF(2),VFR(2),o[0],0,0,0), C1,0); \
    KRD(GL,3); GAPB(o[1]=__builtin_amdgcn_mfma_f32_32x32x16_bf16(PAF(2),VFR(6),o[1],0,0,0), C1,4); \
    GAPB(o[0]=__builtin_amdgcn_mfma_f32_32x32x16_bf16(PAF(3),VFR(3),o[0],0,0,0), C1,8); \
    GAPB(o[1]=__builtin_amdgcn_mfma_f32_32x32x16_bf16(PAF(3),VFR(7),o[1],0,0,0), C1,12); \
    }while(0)
  int t=1;
  #undef CMASK
  #define CMASK(P0,P1,t) do{}while(0)
  for(;t+5<NT;t+=2){
    STEP(pB0,pB1,pA0,pA1,t,true,true,true);     WAIT_BAR(2); RESC(); ROT();
    STEP(pA0,pA1,pB0,pB1,t+1,true,true,true);   WAIT_BAR(2); RESC(); ROT();
  }
  #undef CMASK
  #define CMASK(P0,P1,t) do{int jb_=(t)-(NT-4); if(jb_>=0)cmask(P0,P1,jb_,qrel,hi);}while(0)
  #define ENDW(tt) do{ if((tt)+3<NT){WAIT_BAR(2);} else if((tt)+2<NT){WAIT_BAR(1);} else {WAIT_BAR(0);} }while(0)
  for(;t+1<NT;t+=2){
    STEP(pB0,pB1,pA0,pA1,t,(t+3<NT),(t+1<NT),(t+1<NT));       ENDW(t);   RESC(); ROT();
    STEP(pA0,pA1,pB0,pB1,t+1,(t+4<NT),(t+2<NT),(t+2<NT));     ENDW(t+1); RESC(); ROT();
  }
  STEP(pB0,pB1,pA0,pA1,NT-1,false,false,false); RESC();
  { float sacc=pB0[0]+pB0[1]; _Pragma("unroll") for(int r=2;r<16;++r)sacc+=pB0[r]; _Pragma("unroll") for(int r=0;r<16;++r)sacc+=pB1[r]; l_reg+=sacc;
    pw0=(u32x4){PKW(pB0,0),PKW(pB0,2),PKW(pB0,4),PKW(pB0,6)};pw1=(u32x4){PKW(pB0,8),PKW(pB0,10),PKW(pB0,12),PKW(pB0,14)};pw2=(u32x4){PKW(pB1,0),PKW(pB1,2),PKW(pB1,4),PKW(pB1,6)};pw3=(u32x4){PKW(pB1,8),PKW(pB1,10),PKW(pB1,12),PKW(pB1,14)};
    SBAR(); pv(o,vb0+sl_cur,PAF(0),PAF(1),PAF(2),PAF(3)); }
  #undef PKW
  #undef PAF
  #undef VFR
  #undef PIN
  #undef MX3
  #undef GAPA
  #undef GAPB
  #undef EX
  #undef VRD
  #undef KRD
  #undef STEP
  #undef ENDW
  int unext_=0; if(tid==0) unext_=(int)atomicAdd(counter,1u);
  {auto rr=__builtin_amdgcn_permlane32_swap(__float_as_uint(l_reg),__float_as_uint(l_reg),false,false);l_reg=__uint_as_float(rr[0])+__uint_as_float(rr[1]);}
  if(hi==0)wsf[32+r32]=l_reg;asm volatile("s_waitcnt lgkmcnt(0)":::"memory");
  float rli[16];
  #pragma unroll
  for(int r=0;r<16;++r)rli[r]=__builtin_amdgcn_rcpf(wsf[32+crow(r,hi)]);
  bf16*Ow=O+(rowbase+q0+wid*QBLK)*DM+h*D;
  { bf16*stg=(bf16*)(shm+LDS_OST)+wid*2048;
    #pragma unroll
    for(int r=0;r<16;++r){const int orow=crow(r,hi);
      #pragma unroll
      for(int d0=0;d0<2;++d0)stg[orow*64+d0*32+r32]=__float2bfloat16(o[d0][r]*rli[r]);}
    asm volatile("s_waitcnt lgkmcnt(0)":::"memory");
    const bf16*Gw=G+(rowbase+q0+wid*QBLK)*DM+h*D;
    u32x4 gv4[4];
    #pragma unroll
    for(int i=0;i<4;++i)gv4[i]=*(const u32x4*)(Gw+(long)(i*8+(lane>>3))*DM+(lane&7)*8);
    #pragma unroll
    for(int i=0;i<4;++i){const int row=i*8+(lane>>3),ch=lane&7; const u32x4 v=*(const u32x4*)(stg+row*64+ch*8); const u32x4 gv=gv4[i]; u32x4 w;
      #pragma unroll
      for(int c=0;c<4;++c){ const float ol=__uint_as_float(v[c]<<16), oh=__uint_as_float(v[c]&0xffff0000u), gl=__uint_as_float(gv[c]<<16), gh=__uint_as_float(gv[c]&0xffff0000u);
        const float rl=ol*gl*__builtin_amdgcn_rcpf(1.f+__expf(-gl)), rh=oh*gh*__builtin_amdgcn_rcpf(1.f+__expf(-gh)); w[c]=cvtpk_s(rl,rh); }
      ATTN_STORE16(Ow+(long)row*DM+ch*8,w);} }
  if(tid==0) *(volatile __attribute__((address_space(3))) int*)((__attribute__((address_space(3))) char*)shm+LDS_MISC)=unext_;
  asm volatile("s_waitcnt lgkmcnt(0)\n\ts_barrier":::"memory");
  #undef DMA_K
  #undef DMA_V
  #undef CMASK
  #undef START
  #undef RESC
  #undef ROT
  #undef BIAS
}

template<int THRL> __device__ __forceinline__ void fox_attn_phase(char*lds,const bf16*Q,const bf16*K,const bf16*V,bf16*O,const bf16*G,const float*__restrict__ cumf,unsigned*counter,float TH,float mfix){
  const int tid=threadIdx.x,lane=tid&63; const int wid=__builtin_amdgcn_readfirstlane(tid>>6);
  if(wid>=4) __builtin_amdgcn_s_setprio(1);
  volatile __attribute__((address_space(3))) int* shi=(volatile __attribute__((address_space(3))) int*)((__attribute__((address_space(3))) char*)lds+LDS_MISC);
  volatile __attribute__((address_space(3))) int* Wb=shi+16; volatile __attribute__((address_space(3))) int* sorted=shi+48;
  { const int nbr=4*(NQB-1);
    int u0_=0; if(tid==0) u0_=(int)atomicAdd(counter,1u);
    float cr_[4],ea_[4],eb_[4];
    #pragma unroll
    for(int hh=0;hh<4;++hh){ const float* cfr=cumf+(long)(wid*4+hh)*SEQ; cr_[hh]=cfr[(NQB-1)*QB]; ea_[hh]=(lane<nbr)?cfr[64*lane+63]:0.f; eb_[hh]=(lane+64<nbr)?cfr[64*(lane+64)+63]:0.f; }
    #pragma unroll
    for(int hh=0;hh<4;++hh){ const int bhh=wid*4+hh;
      bool k0=true,k1=true; if(lane<nbr) k0=(cr_[hh]-ea_[hh])>=-TH; if(lane+64<nbr) k1=(cr_[hh]-eb_[hh])>=-TH;
      const unsigned long long m0=__ballot(k0), m1=__ballot(k1);
      int first=m0?__builtin_ctzll(m0):(m1?64+__builtin_ctzll(m1):128); if(first>nbr)first=nbr;
      if(lane==0) Wb[bhh]=nbr-first; }
    if(tid==0) shi[0]=u0_;
    __syncthreads();
    if(wid==0){ const int myW=(lane<32)?Wb[lane]:-1; int rank=0;
      for(int j=0;j<32;++j){ const int wj=Wb[j]; rank+=((wj>myW)||(wj==myW&&j<lane))?1:0; }
      if(lane<32) sorted[rank]=lane; }
    __syncthreads(); }
  for(;;){
    const int u=shi[0];
    if(u>=NQB*BATCH*NHEAD) break;
    const int qb=NQB-1-(u&31), bh=sorted[u>>5], q0=qb*QB;
    const float* cf=cumf+(long)bh*SEQ;
    const float cref=cf[q0];
    const int nb=4*qb; float e0=0.f,e1=0.f;
    if(lane<nb) e0=cf[64*lane+63];
    if(lane+64<nb) e1=cf[64*(lane+64)+63];
    const float cqr=cf[q0+wid*QBLK+(lane&31)];
    int t0;
    { bool k0=true,k1=true;
      if(lane<nb) k0=(cref-e0)>=-TH;
      if(lane+64<nb) k1=(cref-e1)>=-TH;
      const unsigned long long m0=__ballot(k0), m1=__ballot(k1);
      int first=m0?__builtin_ctzll(m0):(m1?64+__builtin_ctzll(m1):128); if(first>nb)first=nb;
      t0=__builtin_amdgcn_readfirstlane(first&~1); }
    const float cqv=(cqr-cref)*1.4426950408889634f;
    attn_unit<THRL>(bh/NHEAD,bh%NHEAD,qb,t0,cqv,mfix,cf,cref,counter,Q,K,V,O,G,lds);
  }
  __builtin_amdgcn_s_setprio(0);
}
#undef SBAR
#undef WAIT_BAR
}

#include <hip/hip_cooperative_groups.h>
namespace cg = cooperative_groups;
#define LAS __attribute__((address_space(3)))
typedef unsigned short bf16;
typedef unsigned v4u __attribute__((ext_vector_type(4)));
typedef unsigned v2u __attribute__((ext_vector_type(2)));
typedef float f32x4 __attribute__((ext_vector_type(4)));
typedef short bf16x8 __attribute__((ext_vector_type(8)));
typedef short v4i16_t __attribute__((ext_vector_type(4)));
constexpr int NWAVES = 8, NTHR = 512;
constexpr int M = 16384, D = 1024, SEQL = 8192;
constexpr int N0 = 3072, N1 = 4096, N1L = 4112;
constexpr float EPSN = 1e-6f;
constexpr size_t MiB = 1u << 20;
constexpr size_t WS_CTL = 0, WS_ROWSS = 65536, WS_MOD = 131072, CTL_ZERO_BYTES = 196608;
constexpr int CW_BAR = 4096;
__device__ __forceinline__ unsigned char* ws_ctl_base(unsigned char* ws) { return ws + WS_CTL; }
constexpr size_t WS_BIAS1 = 1 * MiB + 256 * 1024;
constexpr size_t WS_W0IN = 2 * MiB, WS_W0OUT = 8 * MiB, WS_W1IN = 10 * MiB, WS_W1OUT = 19 * MiB, WS_POOLW = 21 * MiB;
constexpr size_t WS_LOGF = 22 * MiB, WS_CUMF = 23 * MiB;
constexpr size_t WS_H = 24 * MiB;
constexpr size_t WS_P0 = 56 * MiB;
constexpr size_t WS_MIX = 152 * MiB;
constexpr size_t WS_LST = 184 * MiB, WS_SST = 200 * MiB, WS_DTOT = 216 * MiB;
constexpr size_t WS_END = 217 * MiB;
constexpr int LDS_BYTES = 147456;

typedef float f32x2_t __attribute__((ext_vector_type(2))); typedef __bf16 bf16x2_t __attribute__((ext_vector_type(2)));
__device__ __forceinline__ unsigned pk2(float lo, float hi) { f32x2_t v = {lo, hi}; bf16x2_t b = __builtin_convertvector(v, bf16x2_t); return __builtin_bit_cast(unsigned, b); }
__device__ __forceinline__ unsigned f2bf(float f) { return pk2(f, 0.f) & 0xffffu; }
__device__ __forceinline__ float bf2f(unsigned short h) { return __uint_as_float((unsigned)h << 16); }
__device__ __forceinline__ float bflo(unsigned w) { return __uint_as_float(w << 16); }
__device__ __forceinline__ float bfhi(unsigned w) { return __uint_as_float(w & 0xffff0000u); }
__device__ __forceinline__ float sigmf(float x) { return __builtin_amdgcn_rcpf(1.f + __builtin_amdgcn_exp2f(x * -1.4426950408889634f)); }
__device__ __forceinline__ float siluf(float x) { return x * sigmf(x); }
__device__ __forceinline__ float wave_sum(float v) {
#pragma unroll
    for (int o = 1; o < 64; o <<= 1) v += __shfl_xor(v, o);
    return v;
}
__device__ __forceinline__ bf16x8 trfrag(const LAS char* p, int hioff) {
    const v4i16_t lo = __builtin_amdgcn_ds_read_tr16_b64_v4i16((LAS v4i16_t*)p);
    const v4i16_t hi = __builtin_amdgcn_ds_read_tr16_b64_v4i16((LAS v4i16_t*)(p + hioff));
    return (bf16x8){lo[0], lo[1], lo[2], lo[3], hi[0], hi[1], hi[2], hi[3]};
}

__device__ __forceinline__ void transpose_item(const float* W, int K, int N, bf16* WT, int prow0, int k0, int n0, LAS float* scr, int lane) {
    float tv[32];
#pragma unroll
    for (int i = 0; i < 32; ++i) { const int kk = 2 * i + (lane >> 5), c = n0 + (lane & 31); tv[i] = (c < N) ? W[(size_t)(k0 + kk) * N + c] : 0.f; }
#pragma unroll
    for (int i = 0; i < 32; ++i) { const int kk = 2 * i + (lane >> 5); scr[kk * 33 + (lane & 31)] = tv[i]; }
    asm volatile("s_waitcnt lgkmcnt(0)" ::: "memory");
    const int c = lane & 7;
#pragma unroll
    for (int j = 0; j < 4; ++j) { const int n = (lane >> 3) + 8 * j; const LAS float* s = scr + (8 * c) * 33 + n;
        v4u o; o.x = pk2(s[0 * 33], s[1 * 33]); o.y = pk2(s[2 * 33], s[3 * 33]); o.z = pk2(s[4 * 33], s[5 * 33]); o.w = pk2(s[6 * 33], s[7 * 33]);
        *(v4u*)(WT + (size_t)(prow0 + n) * K + k0 + 8 * c) = o; }
    asm volatile("s_waitcnt lgkmcnt(0)" ::: "memory");
}

struct Args { const float* in[16]; float* out; unsigned char* ws; };

__device__ __forceinline__ void weight_copy_items(const Args& a, LAS unsigned char* lds, int lo, int hi, int G) {
    int tid = threadIdx.x; asm volatile("" : "+v"(tid)); const int lane = tid & 63, wave = tid >> 6;
    unsigned char* ws = a.ws;
    LAS float* scr = (LAS float*)(lds + wave * 16384);
    constexpr int I0 = 16 * 96, I4 = 4 * 2 * 4, I1 = 16 * 32, I2 = 16 * 129, I3 = 16 * 32;
    for (int it = lo + (int)blockIdx.x * NWAVES + wave; it < hi; it += G * NWAVES) {
        int r = it;
        if (r < I0) { const int kb = r / 96, nb = r % 96; transpose_item(a.in[6], D, N0, (bf16*)(ws + WS_W0IN), 32 * nb, 64 * kb, 32 * nb, scr, lane); continue; } r -= I0;
        if (r < I4) { const int gi = r >> 3, kb = (r >> 2) & 1, nb = r & 3; transpose_item(a.in[8] + (size_t)gi * 128 * 128, 128, 128, (bf16*)(ws + WS_POOLW) + (size_t)gi * 128 * 128, 32 * nb, 64 * kb, 32 * nb, scr, lane); continue; } r -= I4;
        if (r < I1) { const int kb = r / 32, nb = r % 32; transpose_item(a.in[10], D, D, (bf16*)(ws + WS_W0OUT), 32 * nb, 64 * kb, 32 * nb, scr, lane); continue; } r -= I1;
        if (r < I2) { const int kb = r / 129, lg = r % 129; const int pg = lg < 128 ? (8 * (lg >> 3) + 4 * (lg & 1) + ((lg & 7) >> 1)) : 128;
            transpose_item(a.in[11], D, N1L, (bf16*)(ws + WS_W1IN), 32 * pg, 64 * kb, 32 * lg, scr, lane); continue; } r -= I2;
        { const int kb = r / 32, nb = r % 32; transpose_item(a.in[15], D, D, (bf16*)(ws + WS_W1OUT), 32 * nb, 64 * kb, 32 * nb, scr, lane); }
    }
}

__device__ __forceinline__ void prologue_phase(const Args& a, LAS unsigned char* lds, int G) {
    int tid = threadIdx.x; asm volatile("" : "+v"(tid)); const int lane = tid & 63, wave = tid >> 6;
    unsigned char* ws = a.ws;
    {
        const float* cvec = a.in[1]; const float* ada_w = a.in[3]; const float* ada_b = a.in[4]; float* mod = (float*)(ws + WS_MOD);
        LAS float* red = (LAS float*)(lds + 131072);
        for (int it = blockIdx.x; it < 192; it += G) {
            const int half = it / 96, r = it % 96, l = r / 48, cgp = r % 48, col = cgp * 64 + lane, kb = half * 512 + wave * 64;
            const float* wp = ada_w + (size_t)l * D * 3072 + (size_t)kb * 3072 + col;
            float wv[64];
#pragma unroll
            for (int k = 0; k < 64; ++k) wv[k] = wp[(size_t)k * 3072];
            float a0 = 0.f, a1 = 0.f;
#pragma unroll
            for (int k = 0; k < 64; ++k) { const float c0 = cvec[kb + k], c1 = cvec[D + kb + k]; a0 += siluf(c0) * wv[k]; a1 += siluf(c1) * wv[k]; }
            red[(wave * 2 + 0) * 64 + lane] = a0; red[(wave * 2 + 1) * 64 + lane] = a1;
            __syncthreads();
            if (wave < 2) { float s = half == 0 ? ada_b[l * 3072 + col] : 0.f;
#pragma unroll
                for (int w = 0; w < 8; ++w) s += red[(w * 2 + wave) * 64 + lane];
                atomicAdd(mod + (l * 2 + wave) * 3072 + col, s); }
            __syncthreads();
        }
    }
    weight_copy_items(a, lds, 0, 16 * 96 + 32, G);
}

__device__ __forceinline__ void norm_mod_phase(const float* X, const float* ng, const float* mod, bf16* H, int G) {
    int tid = threadIdx.x; asm volatile("" : "+v"(tid)); const int lane = tid & 63, wave = tid >> 6;
    const int gw = blockIdx.x * NWAVES + wave, NGW = G * NWAVES;
#pragma unroll 1
    for (int b = 0; b < 2; ++b) {
        f32x4 gs[4], sh[4];
#pragma unroll
        for (int j = 0; j < 4; ++j) { const int c = 4 * lane + 256 * j; gs[j] = *(const f32x4*)(ng + c) * (*(const f32x4*)(mod + b * 3072 + 1024 + c) + 1.0f); sh[j] = *(const f32x4*)(mod + b * 3072 + c); }
        for (int tb = gw; tb < SEQL; tb += 4 * NGW) {
            f32x4 v[4][4]; float s[4]; int mr[4]; bool has[4];
#pragma unroll
            for (int r = 0; r < 4; ++r) { const int t = tb + r * NGW; has[r] = t < SEQL; mr[r] = b * SEQL + (has[r] ? t : tb); const f32x4* xr = (const f32x4*)(X + (size_t)mr[r] * D) + lane;
#pragma unroll
                for (int j = 0; j < 4; ++j) v[r][j] = xr[64 * j]; }
#pragma unroll
            for (int r = 0; r < 4; ++r) { float q = 0.f;
#pragma unroll
                for (int j = 0; j < 4; ++j) q += (v[r][j].x * v[r][j].x + v[r][j].y * v[r][j].y) + (v[r][j].z * v[r][j].z + v[r][j].w * v[r][j].w);
                s[r] = q; }
#pragma unroll
            for (int o = 1; o < 64; o <<= 1) {
#pragma unroll
                for (int r = 0; r < 4; ++r) s[r] += __shfl_xor(s[r], o); }
#pragma unroll
            for (int r = 0; r < 4; ++r) { if (!has[r]) continue;
                const float rs = __builtin_amdgcn_rsqf(s[r] * (1.f / D) + EPSN); v2u* o8 = (v2u*)(H + (size_t)mr[r] * D) + lane;
#pragma unroll
                for (int j = 0; j < 4; ++j) { const f32x4 h = v[r][j] * rs * gs[j] + sh[j]; o8[64 * j] = (v2u){pk2(h.x, h.y), pk2(h.z, h.w)}; } }
        }
    }
}

constexpr int RS = 272;
template <int W> __device__ __forceinline__ void pool_fill(LAS unsigned char* Al, const LAS unsigned char* Ul, int tid, int tt0) {
    const int t = tid >> 2, cq = tid & 3; const int tt = tt0 + t; const int cnt = tt + 1 < W ? tt + 1 : W;
    const float inv = 1.0f / (float)cnt;
#pragma unroll
    for (int ch = 0; ch < 4; ++ch) {
        float acc[8];
#pragma unroll
        for (int e = 0; e < 8; ++e) acc[e] = 0.f;
        v4u self = (v4u){0u, 0u, 0u, 0u};
#pragma unroll
        for (int j = 0; j < W; ++j) { const v4u x = *(const LAS v4u*)(Ul + (t + 15 - j) * RS + (cq * 32 + ch * 8) * 2); if (j == 0) self = x;
#pragma unroll
            for (int e = 0; e < 4; ++e) { acc[2 * e] += bflo(x[e]); acc[2 * e + 1] += bfhi(x[e]); } }
        v4u o;
#pragma unroll
        for (int e = 0; e < 4; ++e) o[e] = pk2(acc[2 * e] * inv - bflo(self[e]), acc[2 * e + 1] * inv - bfhi(self[e]));
        *(LAS v4u*)(Al + t * RS + (cq * 32 + ch * 8) * 2) = o;
    }
}
__device__ __forceinline__ void pool_unit(LAS unsigned char* lds, int unit, const bf16* P0, const bf16* PWt, const float* pscale, bf16* MIX) {
    int tid = threadIdx.x; asm volatile("" : "+v"(tid)); const int lane = tid & 63, wave = tid >> 6, li = lane & 15, g = lane >> 4;
    const int grp = unit < 256 ? (unit & 3) : 3 - (unit & 3), rt = unit >> 2, row0 = rt * 128, tt0 = row0 & 8191;
    LAS unsigned char* Al = lds; LAS unsigned char* Bl = lds + 128 * RS; LAS unsigned char* Ul = lds + 256 * RS;
    {
        const bf16* src = PWt + (size_t)grp * 16384;
        v4u bw[4], uw[5];
#pragma unroll
        for (int j = 0; j < 4; ++j) { const int i = tid + NTHR * j, d = i >> 4, c16 = i & 15; bw[j] = *(const v4u*)(src + d * 128 + c16 * 8); }
#pragma unroll
        for (int j = 0; j < 5; ++j) { const int i = tid + NTHR * j, r = i >> 4, c16 = i & 15; const int tt = tt0 - 15 + r;
            uw[j] = (v4u){0u, 0u, 0u, 0u};
            if (i < 143 * 16 && tt >= 0) uw[j] = *(const v4u*)(P0 + (size_t)(row0 - 15 + r) * N0 + 2048 + grp * 128 + c16 * 8); }
#pragma unroll
        for (int j = 0; j < 4; ++j) { const int i = tid + NTHR * j, d = i >> 4, c16 = i & 15; *(LAS v4u*)(Bl + d * RS + c16 * 16) = bw[j]; }
#pragma unroll
        for (int j = 0; j < 5; ++j) { const int i = tid + NTHR * j, r = i >> 4, c16 = i & 15; if (i < 143 * 16) *(LAS v4u*)(Ul + r * RS + c16 * 16) = uw[j]; }
    }
    __syncthreads();
    if (grp == 0) pool_fill<2>(Al, Ul, tid, tt0); else if (grp == 1) pool_fill<4>(Al, Ul, tid, tt0); else if (grp == 2) pool_fill<8>(Al, Ul, tid, tt0); else pool_fill<16>(Al, Ul, tid, tt0);
    __syncthreads();
    f32x4 acc[8];
#pragma unroll
    for (int db = 0; db < 8; ++db) acc[db] = (f32x4){0.f, 0.f, 0.f, 0.f};
#pragma unroll
    for (int ks = 0; ks < 4; ++ks) {
        const bf16x8 y = *(const LAS bf16x8*)(Al + (16 * wave + li) * RS + (32 * ks + 8 * g) * 2);
#pragma unroll
        for (int db = 0; db < 8; ++db) { const bf16x8 x = *(const LAS bf16x8*)(Bl + (16 * db + li) * RS + (32 * ks + 8 * g) * 2);
            acc[db] = __builtin_amdgcn_mfma_f32_16x16x32_bf16(x, y, acc[db], 0, 0, 0); }
    }
    const int row = row0 + 16 * wave + li;
    v2u gbv[8]; f32x4 psv[8];
#pragma unroll
    for (int db = 0; db < 8; ++db) { const int dcol = grp * 128 + 16 * db + 4 * g; gbv[db] = *(const v2u*)(P0 + (size_t)row * N0 + 2560 + dcol); psv[db] = *(const f32x4*)(pscale + dcol); }
#pragma unroll
    for (int db = 0; db < 8; ++db) { const int dcol = grp * 128 + 16 * db + 4 * g;
        const v2u gb = gbv[db]; const f32x4 ps = psv[db];
        const float o0 = acc[db][0] * ps[0] * siluf(bflo(gb[0])), o1 = acc[db][1] * ps[1] * siluf(bfhi(gb[0])), o2 = acc[db][2] * ps[2] * siluf(bflo(gb[1])), o3 = acc[db][3] * ps[3] * siluf(bfhi(gb[1]));
        *(v2u*)(MIX + (size_t)row * D + 512 + dcol) = (v2u){pk2(o0, o1), pk2(o2, o3)}; }
    __syncthreads();
}

constexpr int HL_V = 0, HL_QT = 8704, HL_KT = 17408, HL_KE = 26112, HL_SC = 36352, HL_TOT = 38912, HL_DEC = 40960, HL_OUT = 41472, HL_S = 58368;
template <bool PC> __device__ __forceinline__ void hgrn_unit(LAS unsigned char* lds, int unit, const bf16* P0, const float* lbp, const float* ong, float* Lst, const float* Sst, float* Dtot, bf16* MIX) {
    int tid = threadIdx.x; asm volatile("" : "+v"(tid)); const int lane = tid & 63, wave = tid >> 6, li = lane & 15, g = lane >> 4, q4 = li >> 2, p4 = li & 3;
    if (__builtin_amdgcn_readfirstlane(wave) >= 4) __builtin_amdgcn_s_setprio(1);
    const int b = unit >> 7, hd = (unit >> 5) & 3, sc = unit & 31;
    const int row0 = b * SEQL + sc * 256;
    const int k = 16 * wave + li, tq = g;
    unsigned nf[8], nq[8]; v4u nv, ng = (v4u){0u, 0u, 0u, 0u};
#define HG_LOAD(step_) do { const int r0_ = row0 + (step_) * 32; const bf16* fp_ = P0 + (size_t)(r0_ + 8 * tq) * N0 + 512 + hd * 128 + k; \
        _Pragma("unroll") for (int t_ = 0; t_ < 8; ++t_) { nf[t_] = fp_[(size_t)t_ * N0]; if (PC) nq[t_] = fp_[(size_t)t_ * N0 - 512]; } \
        nv = *(const v4u*)(P0 + (size_t)(r0_ + (tid >> 4)) * N0 + 1024 + hd * 128 + (tid & 15) * 8); \
        if (PC) ng = *(const v4u*)(P0 + (size_t)(r0_ + (tid >> 4)) * N0 + 1536 + hd * 128 + (tid & 15) * 8); } while (0)
#define HB() asm volatile("s_waitcnt lgkmcnt(0)\n\ts_barrier" ::: "memory")
    HG_LOAD(0);
    const float a0 = lbp[hd * 128 + k], a1 = lbp[512 + hd * 128 + k], a2 = lbp[1024 + hd * 128 + k];
    f32x4 S[8];
    f32x4 g0 = (f32x4){0.f, 0.f, 0.f, 0.f}, g1 = g0;
    if (PC) {
#pragma unroll
        for (int kb = 0; kb < 8; ++kb) S[kb] = *(const f32x4*)(Sst + (size_t)unit * 16384 + (16 * kb + li) * 128 + 16 * wave + 4 * g);
        g0 = *(const f32x4*)(ong + hd * 128 + 8 * (tid & 15)); g1 = *(const f32x4*)(ong + hd * 128 + 8 * (tid & 15) + 4);
    } else {
#pragma unroll
        for (int kb = 0; kb < 8; ++kb) S[kb] = (f32x4){0.f, 0.f, 0.f, 0.f};
    }
    float lb;
    { const float mx = fmaxf(a0, fmaxf(a1, a2)); const float e0 = __expf(a0 - mx), e1 = __expf(a1 - mx), e2 = __expf(a2 - mx); lb = e0 / (e0 + e1 + e2); }
    if (PC) {
#pragma unroll
        for (int kb = 0; kb < 8; ++kb) *(LAS v2u*)(lds + HL_S + (16 * kb + li) * RS + (16 * wave + 4 * g) * 2) = (v2u){pk2(S[kb][0], S[kb][1]), pk2(S[kb][2], S[kb][3])};
    }
    float sumlog = 0.f;
    LAS float* DEC = (LAS float*)(lds + HL_DEC);
#pragma unroll 1
    for (int step = 0; step < 8; ++step) {
        const int r0 = row0 + step * 32;
        float lf[8], ky[8], qv[8];
        {
#pragma unroll
          for (int t = 0; t < 8; ++t) { const float f = __uint_as_float(nf[t] << 16); const float sg = sigmf(f); const float fg = lb + (1.f - lb) * sg; lf[t] = __builtin_amdgcn_logf(fg); ky[t] = 1.f - fg;
              if (PC) qv[t] = __uint_as_float(nq[t] << 16); }
        }
        const v4u cv = nv, ga = ng;
        if (step < 7) HG_LOAD(step + 1);
#pragma unroll
        for (int t = 1; t < 8; ++t) lf[t] += lf[t - 1];
        { const int s = tid >> 4, c16 = tid & 15; *(LAS v4u*)(lds + HL_V + s * RS + c16 * 16) = cv; }
        float pre, cl;
        { const float T = lf[7]; const float p1 = __shfl_up(T, 16), p2 = __shfl_up(T, 32), p3 = __shfl_up(T, 48);
          pre = (tq >= 1 ? p1 : 0.f) + (tq >= 2 ? p2 : 0.f) + (tq >= 3 ? p3 : 0.f);
          const float s2 = T + __shfl_xor(T, 16); cl = s2 + __shfl_xor(s2, 32); }
        const float ecl = __builtin_amdgcn_exp2f(cl);
        { unsigned kw[4];
#pragma unroll
          for (int t = 0; t < 8; t += 2) { const float c0 = pre + lf[t], c1 = pre + lf[t + 1];
              const float k0 = ky[t] * __builtin_amdgcn_exp2f(-c0), k1 = ky[t + 1] * __builtin_amdgcn_exp2f(-c1);
              kw[t >> 1] = pk2(k0 * ecl, k1 * ecl);
              if (PC) { const unsigned kk = pk2(k0, k1), qq = pk2(qv[t] * __builtin_amdgcn_exp2f(c0), qv[t + 1] * __builtin_amdgcn_exp2f(c1));
                  *(LAS unsigned short*)(lds + HL_KT + (8 * tq + t) * RS + k * 2) = (unsigned short)(kk & 0xffffu);
                  *(LAS unsigned short*)(lds + HL_KT + (8 * tq + t + 1) * RS + k * 2) = (unsigned short)(kk >> 16);
                  *(LAS unsigned short*)(lds + HL_QT + (8 * tq + t) * RS + k * 2) = (unsigned short)(qq & 0xffffu);
                  *(LAS unsigned short*)(lds + HL_QT + (8 * tq + t + 1) * RS + k * 2) = (unsigned short)(qq >> 16); } }
          *(LAS v4u*)(lds + HL_KE + k * 80 + tq * 16) = (v4u){kw[0], kw[1], kw[2], kw[3]}; }
        if (tq == 0) DEC[k] = ecl;
        sumlog += cl;
        HB();
        if (PC) {
            if (wave < 4) {
                const int ti = wave >> 1, si = wave & 1;
                f32x4 a = (f32x4){0.f, 0.f, 0.f, 0.f};
                if (si <= ti) {
#pragma unroll
                    for (int ks = 0; ks < 4; ++ks) { const bf16x8 x = *(const LAS bf16x8*)(lds + HL_KT + (16 * si + li) * RS + (32 * ks + 8 * g) * 2);
                        const bf16x8 y = *(const LAS bf16x8*)(lds + HL_QT + (16 * ti + li) * RS + (32 * ks + 8 * g) * 2);
                        a = __builtin_amdgcn_mfma_f32_16x16x32_bf16(x, y, a, 0, 0, 0); }
                    if (si == ti) {
#pragma unroll
                        for (int r = 0; r < 4; ++r) if (4 * g + r > li) a[r] = 0.f;
                    }
                }
                *(LAS v2u*)(lds + HL_SC + (16 * ti + li) * 80 + (16 * si + 4 * g) * 2) = (v2u){pk2(a[0], a[1]), pk2(a[2], a[3])};
            }
            HB();
        }
        const bf16x8 xv = trfrag((const LAS char*)(lds + HL_V + (8 * g + q4) * RS + (16 * wave + 4 * p4) * 2), 4 * RS);
        bf16x8 xs[4], yq[2][4], ysc[2], yk[8]; float dcv[8];
        if (PC) {
#pragma unroll
            for (int tb = 0; tb < 2; ++tb) ysc[tb] = *(const LAS bf16x8*)(lds + HL_SC + (16 * tb + li) * 80 + g * 16);
#pragma unroll
            for (int ks = 0; ks < 4; ++ks) { xs[ks] = trfrag((const LAS char*)(lds + HL_S + (32 * ks + 8 * g + q4) * RS + (16 * wave + 4 * p4) * 2), 4 * RS);
#pragma unroll
                for (int tb = 0; tb < 2; ++tb) yq[tb][ks] = *(const LAS bf16x8*)(lds + HL_QT + (16 * tb + li) * RS + (32 * ks + 8 * g) * 2); }
        }
#pragma unroll
        for (int kb = 0; kb < 8; ++kb) { dcv[kb] = DEC[16 * kb + li]; yk[kb] = *(const LAS bf16x8*)(lds + HL_KE + (16 * kb + li) * 80 + g * 16); }
        __builtin_amdgcn_sched_barrier(0);
        if (PC) {
            f32x4 o[2];
#pragma unroll
            for (int tb = 0; tb < 2; ++tb) o[tb] = __builtin_amdgcn_mfma_f32_16x16x32_bf16(xv, ysc[tb], (f32x4){0.f, 0.f, 0.f, 0.f}, 0, 0, 0);
#pragma unroll
            for (int ks = 0; ks < 4; ++ks)
#pragma unroll
                for (int tb = 0; tb < 2; ++tb) o[tb] = __builtin_amdgcn_mfma_f32_16x16x32_bf16(xs[ks], yq[tb][ks], o[tb], 0, 0, 0);
#pragma unroll
            for (int tb = 0; tb < 2; ++tb) *(LAS f32x4*)(lds + HL_OUT + ((16 * tb + li) * 132 + 16 * wave + 4 * g) * 4) = o[tb];
        }
#pragma unroll
        for (int kb = 0; kb < 8; ++kb) S[kb] = __builtin_amdgcn_mfma_f32_16x16x32_bf16(xv, yk[kb], S[kb] * dcv[kb], 0, 0, 0);
        HB();
        if (PC) {
#pragma unroll
            for (int kb = 0; kb < 8; ++kb) *(LAS v2u*)(lds + HL_S + (16 * kb + li) * RS + (16 * wave + 4 * g) * 2) = (v2u){pk2(S[kb][0], S[kb][1]), pk2(S[kb][2], S[kb][3])};
            const int t = tid >> 4, vg = tid & 15;
            const f32x4 o0 = *(const LAS f32x4*)(lds + HL_OUT + (t * 132 + 8 * vg) * 4), o1 = *(const LAS f32x4*)(lds + HL_OUT + (t * 132 + 8 * vg + 4) * 4);
            float ss = (o0[0] * o0[0] + o0[1] * o0[1]) + (o0[2] * o0[2] + o0[3] * o0[3]) + (o1[0] * o1[0] + o1[1] * o1[1]) + (o1[2] * o1[2] + o1[3] * o1[3]);
            ss += __shfl_xor(ss, 1); ss += __shfl_xor(ss, 2); ss += __shfl_xor(ss, 4); ss += __shfl_xor(ss, 8);
            const float rstd = __builtin_amdgcn_rsqf(ss * (1.f / 128.f) + EPSN);
            const int col = hd * 128 + 8 * vg;
            v4u w;
            w[0] = pk2(o0[0] * rstd * g0[0] * siluf(bflo(ga[0])), o0[1] * rstd * g0[1] * siluf(bfhi(ga[0])));
            w[1] = pk2(o0[2] * rstd * g0[2] * siluf(bflo(ga[1])), o0[3] * rstd * g0[3] * siluf(bfhi(ga[1])));
            w[2] = pk2(o1[0] * rstd * g1[0] * siluf(bflo(ga[2])), o1[1] * rstd * g1[1] * siluf(bfhi(ga[2])));
            w[3] = pk2(o1[2] * rstd * g1[2] * siluf(bflo(ga[3])), o1[3] * rstd * g1[3] * siluf(bfhi(ga[3])));
            *(v4u*)(MIX + (size_t)(r0 + t) * D + col) = w;
        }
    }
    if (!PC) {
#pragma unroll
        for (int kb = 0; kb < 8; ++kb) *(f32x4*)(Lst + (size_t)unit * 16384 + (16 * kb + li) * 128 + 16 * wave + 4 * g) = S[kb];
        if (tq == 0) Dtot[unit * 128 + k] = __builtin_amdgcn_exp2f(sumlog);
    }
    __builtin_amdgcn_s_setprio(0);
    __syncthreads();
#undef HG_LOAD
#undef HB
}

__device__ __forceinline__ void hgrn_scan_phase(const float* __restrict__ Lst, const float* __restrict__ Dtot, float* __restrict__ Sst, int G) {
    int tid = threadIdx.x; asm volatile("" : "+v"(tid));
    for (int e = blockIdx.x * NTHR + tid; e < 8 * 16384; e += G * NTHR) {
        const int bh = e >> 14, kv = e & 16383, kk = kv >> 7;
        float s = 0.f;
#pragma unroll 8
        for (int sc = 0; sc < 32; ++sc) { const size_t u = (size_t)(bh * 32 + sc);
            Sst[u * 16384 + kv] = s;
            s = Dtot[u * 128 + kk] * s + Lst[u * 16384 + kv]; }
    }
}

__device__ __forceinline__ void bias1_phase(const bf16* W1t, const float* mod1, float* biasp, int G) {
    int tid = threadIdx.x; asm volatile("" : "+v"(tid)); const int lane = tid & 63, wave = tid >> 6;
    for (int p = blockIdx.x * NWAVES + wave; p < 4112; p += G * NWAVES) {
        float s0 = 0.f, s1 = 0.f;
#pragma unroll
        for (int j = 0; j < 2; ++j) { const int k0 = 8 * lane + 512 * j; const v4u w = *(const v4u*)(W1t + (size_t)p * D + k0);
#pragma unroll
            for (int e = 0; e < 4; ++e) { const float wl = bflo(w[e]), wh = bfhi(w[e]);
                s0 += wl * mod1[k0 + 2 * e] + wh * mod1[k0 + 2 * e + 1]; s1 += wl * mod1[3072 + k0 + 2 * e] + wh * mod1[3072 + k0 + 2 * e + 1]; } }
        s0 = wave_sum(s0); s1 = wave_sum(s1);
        if (lane == 0) { biasp[p] = s0; biasp[4352 + p] = s1; }
    }
}

__device__ __forceinline__ void fl_phase(const bf16* H, const bf16* Wfl, const float* bfv, const float* rowss, const float* biasp, float* logf, int G) {
    int tid = threadIdx.x; asm volatile("" : "+v"(tid)); const int lane = tid & 63, wave = tid >> 6, li = lane & 15, g = lane >> 4;
    for (int rb = blockIdx.x + G * wave; rb < M / 16; rb += G * NWAVES) {
        const bf16* ap = H + (size_t)(16 * rb + li) * D + 8 * g; const bf16* bp = Wfl + (size_t)li * D + 8 * g;
        f32x4 acc = (f32x4){0.f, 0.f, 0.f, 0.f};
#pragma unroll 8
        for (int ks = 0; ks < 32; ++ks) { const bf16x8 a = *(const bf16x8*)(ap + 32 * ks), b = *(const bf16x8*)(bp + 32 * ks);
            acc = __builtin_amdgcn_mfma_f32_16x16x32_bf16(a, b, acc, 0, 0, 0); }
        const int row = 16 * rb + 4 * g, bb = row >> 13, t = row & 8191; const float bias = bfv[li] + biasp[bb * 4352 + 4096 + li];
        const f32x4 rq = *(const f32x4*)(rowss + row);
        f32x4 o;
#pragma unroll
        for (int r = 0; r < 4; ++r) { const float z = acc[r] * __builtin_amdgcn_rsqf(rq[r] * (1.0f / 1024.0f) + EPSN) + bias; o[r] = fminf(z, 0.f) - log1pf(__expf(-fabsf(z))); }
        *(f32x4*)(logf + (size_t)(bb * 16 + li) * SEQL + t) = o;
    }
}

__device__ __forceinline__ void cumf_phase(LAS unsigned char* lds, const float* logf, float* cumf, int G) {
    int tid = threadIdx.x; asm volatile("" : "+v"(tid)); const int lane = tid & 63, wave = tid >> 6;
    LAS float* wt = (LAS float*)lds;
    for (int bh = blockIdx.x; bh < 32; bh += G) {
        const f32x4* src = (const f32x4*)(logf + (size_t)bh * SEQL + 16 * tid);
        f32x4 v[4]; float run = 0.f;
#pragma unroll
        for (int j = 0; j < 4; ++j) { v[j] = src[j]; v[j].x += run; v[j].y += v[j].x; v[j].z += v[j].y; v[j].w += v[j].z; run = v[j].w; }
        float inc = run;
#pragma unroll
        for (int o = 1; o < 64; o <<= 1) { const float n = __shfl_up(inc, o); if (lane >= o) inc += n; }
        if (lane == 63) wt[wave] = inc;
        __syncthreads();
        float base = inc - run;
        for (int w = 0; w < wave; ++w) base += wt[w];
        f32x4* dst = (f32x4*)(cumf + (size_t)bh * SEQL + 16 * tid);
#pragma unroll
        for (int j = 0; j < 4; ++j) dst[j] = v[j] + base;
        __syncthreads();
    }
}

#define GAS __attribute__((address_space(1)))
#define RLX_AGENT __ATOMIC_RELAXED, __HIP_MEMORY_SCOPE_AGENT
#define XB_TMO      128
#define XB_XCNT(j)  (256  + 64 * (j))
#define XB_XSUB(j)  (1280 + 64 * (j))
#define XB_XGEN(j)  (2304 + 64 * (j))
#define XB_TOP      3328
#define XB_TOPGEN   3392
#define XCD_BAR_WORDS 3456
#define XB_SPIN_CAP (1u << 18)

__device__ __forceinline__ unsigned xb_ld(unsigned* p)              { return __hip_atomic_load(p, __ATOMIC_RELAXED, __HIP_MEMORY_SCOPE_AGENT); }
__device__ __forceinline__ unsigned xb_add(unsigned* p, unsigned v) { return __hip_atomic_fetch_add(p, v, __ATOMIC_RELAXED, __HIP_MEMORY_SCOPE_AGENT); }
__device__ __forceinline__ unsigned xb_xcc_id() { return (unsigned)__builtin_amdgcn_s_getreg((3 << 11) | 20) & 0xFu; }
#define XB_SPIN(cond, bar) do { unsigned _sp = 0; while (cond) { __builtin_amdgcn_s_sleep(1); \
    if ((++_sp & 255u) == 0u) { if (xb_ld(&(bar)[XB_TMO])) break; if (_sp > XB_SPIN_CAP) { atomicAdd(&(bar)[XB_TMO], 1u); break; } } } } while (0)

struct XcdBarrier {
    unsigned* bar; unsigned x;
    volatile LAS unsigned* st;
};

__device__ __forceinline__ XcdBarrier xcd_barrier_post(unsigned* bar, volatile LAS unsigned* st) {
    XcdBarrier b; b.bar = bar; b.x = xb_xcc_id(); b.st = st;
    if (threadIdx.x == 0) (void)xb_add(&bar[XB_XCNT(b.x)], 1u);
    return b;
}
__device__ __forceinline__ void xcd_barrier_complete(unsigned* bar, unsigned x, unsigned& nloc, unsigned& nx) {
    const unsigned G = gridDim.x * gridDim.y * gridDim.z;
    unsigned sum, cnt, mine, sp = 0u;
    for (;;) {
        sum = 0u; cnt = 0u; mine = 0u;
#pragma unroll
        for (unsigned j = 0; j < 16; ++j) { const unsigned c = xb_ld(&bar[XB_XCNT(j)]); sum += c; cnt += (c > 0u) ? 1u : 0u; mine = (j == x) ? c : mine; }
        if (sum == G) break;
        __builtin_amdgcn_s_sleep(1);
        if ((++sp & 255u) == 0u) { if (xb_ld(&bar[XB_TMO])) break; if (sp > XB_SPIN_CAP) { atomicAdd(&bar[XB_TMO], 1u); break; } }
    }
    nloc = mine > 0u ? mine : 1u; nx = cnt > 0u ? cnt : 1u;
}

__device__ __forceinline__ void xcd_barrier(const XcdBarrier& b) {
    asm volatile("s_waitcnt vmcnt(0)" ::: "memory");
    __syncthreads();
    if (threadIdx.x == 0) {
        unsigned* bar = b.bar;
        __builtin_amdgcn_s_waitcnt(0);
        unsigned nloc = b.st[0], nx = b.st[1];
        if (nloc == 0u) { xcd_barrier_complete(bar, b.x, nloc, nx); b.st[0] = nloc; b.st[1] = nx; }
        const unsigned old = xb_add(&bar[XB_XSUB(b.x)], 1u);
        const unsigned gen = old / nloc;
        if (old + 1u == (gen + 1u) * nloc) {
            __builtin_amdgcn_fence(__ATOMIC_RELEASE, "agent");
            asm volatile("s_waitcnt vmcnt(0)" ::: "memory");
            const unsigned og = xb_add(&bar[XB_TOP], 1u);
            const unsigned tg = og / nx;
            if (og + 1u == (tg + 1u) * nx) xb_add(&bar[XB_TOPGEN], 1u);
            else XB_SPIN(xb_ld(&bar[XB_TOPGEN]) == tg, bar);
            __builtin_amdgcn_fence(__ATOMIC_ACQUIRE, "agent");
            xb_add(&bar[XB_XGEN(b.x)], 1u);
            asm volatile("s_waitcnt vmcnt(0)" ::: "memory");
        } else {
            XB_SPIN(xb_ld(&bar[XB_XGEN(b.x)]) == gen, bar);
            __builtin_amdgcn_fence(__ATOMIC_ACQUIRE, "agent");
            asm volatile("s_waitcnt vmcnt(0)" ::: "memory");
        }
    }
    __syncthreads();
}

__global__ void __launch_bounds__(NTHR, 2) fwd_megakernel(Args args) {
    extern __shared__ __attribute__((aligned(16))) unsigned char lds_raw[];
    LAS unsigned char* lds = (LAS unsigned char*)lds_raw;
    cg::grid_group grid = cg::this_grid();
    if (gridDim.x == 0x7fffffffu) grid.sync();
    { volatile LAS unsigned* mz = (volatile LAS unsigned*)(lds + LDS_BYTES - 64); if (threadIdx.x < 16) mz[threadIdx.x] = 0u; }
    __syncthreads();
    XcdBarrier xbar = xcd_barrier_post((unsigned*)(ws_ctl_base(args.ws)) + CW_BAR, (volatile LAS unsigned*)(lds + LDS_BYTES - 64));
#ifdef PROBE_DUP_SYNC
#define GSYNC() do { xcd_barrier(xbar); xcd_barrier(xbar); } while (0)
#else
#define GSYNC() xcd_barrier(xbar)
#endif
#ifndef PROBE_MASK
#define PROBE_MASK 0
#endif
#define REP(p) for (int rep_ = 0; rep_ < (((PROBE_MASK >> (p)) & 1) ? 2 : 1); ++rep_)
    const int G = gridDim.x;
    unsigned char* ws = args.ws;
    const float* x = args.in[0];
    float* out = args.out;
    float* mod = (float*)(ws + WS_MOD);
    bf16* H = (bf16*)(ws + WS_H); bf16* P0 = (bf16*)(ws + WS_P0); bf16* MIX = (bf16*)(ws + WS_MIX);
    unsigned* ctl = (unsigned*)(ws + WS_CTL);

    REP(0) { prologue_phase(args, lds, G);
    GSYNC(); }
    REP(1) { norm_mod_phase(x, args.in[2], mod, H, G);
    GSYNC(); }
    REP(2) { pg8::Gemm g{H, (const bf16*)(ws + WS_W0IN), M, N0, D}; pg8::StaticOrder S; S.init(M, N0, G, (int)blockIdx.x);
      pg8::EpiBf16<0> E{P0, N0, nullptr, 0, 0, 1.f};
      pg8::gemm_phase<pg8::EpiBf16<0>, pg8::StaticOrder, true, true>(lds, g, S, E);
    GSYNC(); }
    REP(3) {
    for (int u = blockIdx.x; u < 256; u += G) hgrn_unit<false>(lds, u, P0, args.in[5], args.in[7], (float*)(ws + WS_LST), nullptr, (float*)(ws + WS_DTOT), MIX);
    for (int u = blockIdx.x; u < 512; u += G) pool_unit(lds, u, P0, (const bf16*)(ws + WS_POOLW), args.in[9], MIX);
    weight_copy_items(args, lds, 16 * 96 + 32, 16 * 96 + 32 + 16 * 32 + 16 * 129 + 16 * 32, G);
    GSYNC(); }
    REP(4) { hgrn_scan_phase((const float*)(ws + WS_LST), (const float*)(ws + WS_DTOT), (float*)(ws + WS_SST), G);
    GSYNC(); }
    REP(5) { for (int u = blockIdx.x; u < 256; u += G) hgrn_unit<true>(lds, u, P0, args.in[5], args.in[7], nullptr, (const float*)(ws + WS_SST), nullptr, MIX);
    bias1_phase((const bf16*)(ws + WS_W1IN), mod + 2 * 3072, (float*)(ws + WS_BIAS1), G);
    GSYNC(); }
    REP(6) { pg8::Gemm g{MIX, (const bf16*)(ws + WS_W0OUT), M, D, D}; pg8::StaticOrder S; S.init(M, D, G, (int)blockIdx.x);
      pg8::EpiResid<true> E{3072, out, x, mod + 2048, args.in[2] + D, mod + 2 * 3072 + 1024, H, (float*)(ws + WS_ROWSS)};
      pg8::gemm_phase<pg8::EpiResid<true>, pg8::StaticOrder, true, true>(lds, g, S, E);
    GSYNC(); }
    REP(8) {
        fl_phase(H, (const bf16*)(ws + WS_W1IN) + (size_t)4096 * D, args.in[12], (const float*)(ws + WS_ROWSS), (const float*)(ws + WS_BIAS1), (float*)(ws + WS_LOGF), G);
      pg8::Gemm g{H, (const bf16*)(ws + WS_W1IN), M, N1, D}; pg8::StaticOrder S; S.init(M, N1, G, (int)blockIdx.x);
      pg8::EpiOdd E{attn_body::C2, P0, args.in[13], args.in[14], (const float*)(ws + WS_BIAS1), (const float*)(ws + WS_ROWSS)};
      pg8::gemm_phase<pg8::EpiOdd, pg8::StaticOrder, true, true>(lds, g, S, E);
    GSYNC(); }
    REP(9) { cumf_phase(lds, (const float*)(ws + WS_LOGF), (float*)(ws + WS_CUMF), G);
    GSYNC(); }
    REP(10) {
        float mq = 0.f, mk = 0.f;
        { int tid = threadIdx.x; asm volatile("" : "+v"(tid)); const int lane = tid & 63; mq = fabsf(args.in[13][lane]); mk = fabsf(args.in[14][lane]);
#pragma unroll
          for (int o = 1; o < 64; o <<= 1) { mq = fmaxf(mq, __shfl_xor(mq, o)); mk = fmaxf(mk, __shfl_xor(mk, o)); } }
        const float TH = 30.f + 2.f * 8.f * mq * mk * 1.01f;
        const attn_body::bf16* Qb = (const attn_body::bf16*)P0;
        attn_body::fox_attn_phase<8>((char*)lds_raw, Qb, Qb + (size_t)M * D, Qb + 2 * (size_t)M * D, (attn_body::bf16*)H, (const attn_body::bf16*)MIX,
                                     (const float*)(ws + WS_CUMF), ctl + 64 + 64 * rep_, TH, 8.f * mq * mk * 1.01f * 1.4426950408889634f);
    GSYNC(); }
    { pg8::Gemm g{H, (const bf16*)(ws + WS_W1OUT), M, D, D}; pg8::StaticOrder S; S.init(M, D, G, (int)blockIdx.x);
      pg8::EpiResid<false> E{3072, out, out, mod + 2 * 3072 + 2048, nullptr, nullptr, nullptr, nullptr};
      pg8::gemm_phase<pg8::EpiResid<false>, pg8::StaticOrder, true, true>(lds, g, S, E); }
}

extern "C" void kernel_launch(void* const* d_in, const int* in_sizes, int n_in, void* d_out, int out_size, void* d_ws, size_t ws_size, hipStream_t stream) {
    static int grid = 0;
    if (grid == 0) {
        if (n_in != 16 || out_size != M * D || ws_size < WS_END) { fprintf(stderr, "kernel_launch: unexpected sizes n_in %d out %d ws %zu\n", n_in, out_size, ws_size); grid = -1; return; }
        int dev = 0, cus = 0, per_cu = 0;
        (void)hipGetDevice(&dev); (void)hipDeviceGetAttribute(&cus, hipDeviceAttributeMultiprocessorCount, dev);
        if (hipFuncSetAttribute((const void*)fwd_megakernel, hipFuncAttributeMaxDynamicSharedMemorySize, LDS_BYTES) != hipSuccess) { fprintf(stderr, "kernel_launch: hipFuncSetAttribute failed\n"); grid = -1; return; }
        if (hipOccupancyMaxActiveBlocksPerMultiprocessor(&per_cu, (const void*)fwd_megakernel, NTHR, LDS_BYTES) != hipSuccess || per_cu < 1) { fprintf(stderr, "kernel_launch: occupancy query gave %d\n", per_cu); per_cu = 1; }
        (void)hipGetLastError();
        grid = cus * per_cu;
    }
    if (grid < 0) return;
    (void)hipMemsetAsync((char*)d_ws + WS_CTL, 0, CTL_ZERO_BYTES, stream);
    Args a{};
    for (int i = 0; i < 16; ++i) a.in[i] = (const float*)d_in[i];
    a.out = (float*)d_out; a.ws = (unsigned char*)d_ws;
    void* kargs[] = {&a};
    hipError_t e = hipLaunchCooperativeKernel((const void*)fwd_megakernel, dim3(grid), dim3(NTHR), kargs, LDS_BYTES, stream);
    if (e != hipSuccess) fprintf(stderr, "cooperative launch failed: %s (grid %d)\n", hipGetErrorString(e), grid);
}
```
